# Optimizing an MI355X kernel written in HIP

```python
import math
import jax, jax.numpy as jnp
from jax import lax
import numpy as np

D_MODEL = 1024
BATCH = 8
SEQ = 2048
DEPTH = 1
DEC_BATCH = 128
DEC_SEQ = 1
PAST_LEN = 16384
PAGE_SIZE = 128

RW_HEADS = 8
RW_HEAD_DIM = 64
RW_WIDTH = RW_HEADS * RW_HEAD_DIM
LORA_W = 64
LORA_A = 64
LORA_G = 128
SHIFT_WIDTH = 3 * RW_WIDTH + LORA_W + LORA_A + LORA_G
SSM_WIDTH = 512
SSM_GROUP = 16
SSM_GROUPS = SSM_WIDTH // SSM_GROUP
SSM_STATE = 64
IN_WIDTH = SHIFT_WIDTH + SSM_WIDTH + 2 * D_MODEL
D_FF = 2816
CONV_W = 3
PLE_DIM = 256
EPS = 1e-6
GN_EPS = 64e-5

kernel_name = 'rwkv7_s5_gated_hybrid_step'


def rmsnorm(x, g):
    xf = x.astype(jnp.float32)
    y = xf * lax.rsqrt(jnp.mean(xf * xf, axis=-1, keepdims=True) + EPS)
    return (y * g.astype(jnp.float32)).astype(x.dtype)


def wkv_recurrence(r, w, k, v, kk, a, s0):
    def step(S, inp):
        r_t, w_t, k_t, v_t, kk_t, a_t = inp
        sa = jnp.einsum('bhvk,bhk->bhv', S, -kk_t)
        S = (S * w_t[:, :, None, :]
             + sa[..., None] * (kk_t * a_t)[:, :, None, :]
             + v_t[..., None] * k_t[:, :, None, :])
        y_t = jnp.einsum('bhvk,bhk->bhv', S, r_t)
        return S, y_t
    xs = tuple(jnp.swapaxes(t.astype(jnp.float32), 0, 1) for t in (r, w, k, v, kk, a))
    S, ys = lax.scan(step, s0.astype(jnp.float32), xs)
    return jnp.swapaxes(ys, 0, 1), S


def s5_discretise(A_re, A_im, log_dt, B_re, B_im):
    dt = jnp.exp(log_dt.astype(jnp.float32))[:, None]
    lr, li = A_re.astype(jnp.float32), A_im.astype(jnp.float32)
    mag = jnp.exp(lr * dt)
    ar, ai = mag * jnp.cos(li * dt), mag * jnp.sin(li * dt)
    den = lr * lr + li * li
    fr = ((ar - 1.0) * lr + ai * li) / den
    fi = (ai * lr - (ar - 1.0) * li) / den
    Br, Bi = B_re.astype(jnp.float32), B_im.astype(jnp.float32)
    br = fr[..., None] * Br - fi[..., None] * Bi
    bi = fr[..., None] * Bi + fi[..., None] * Br
    return ar, ai, br, bi


def complex_affine_combine(e1, e2):
    a1r, a1i, b1r, b1i = e1
    a2r, a2i, b2r, b2i = e2
    return (a2r * a1r - a2i * a1i,
            a2r * a1i + a2i * a1r,
            a2r * b1r - a2i * b1i + b2r,
            a2r * b1i + a2i * b1r + b2i)


def layer(x, p, st_shift, st_wkv, st_re, st_im, st_conv, L):
    B, T, _ = x.shape
    f32 = jnp.float32
    h = rmsnorm(x, L['ln1_g'])
    proj = h @ L['w_in']
    p_rw = proj[..., :SHIFT_WIDTH]
    u = proj[..., SHIFT_WIDTH:SHIFT_WIDTH + SSM_WIDTH]
    gate_logits = proj[..., SHIFT_WIDTH + SSM_WIDTH:]

    prev = jnp.concatenate([st_shift[:, None].astype(p_rw.dtype), p_rw[:, :-1]], axis=1)
    xs = p_rw + (prev - p_rw) * L['mu_shift']
    new_shift = p_rw[:, -1]
    r, k, v, xw, xa, xg = jnp.split(
        xs, [RW_WIDTH, 2 * RW_WIDTH, 3 * RW_WIDTH, 3 * RW_WIDTH + LORA_W,
             3 * RW_WIDTH + LORA_W + LORA_A], axis=-1)
    wlog = -jax.nn.softplus(-(L['w0'] + jnp.tanh(xw) @ L['w2'])) - 0.5
    decay = jnp.exp(-jnp.exp(wlog.astype(f32)))
    a = jax.nn.sigmoid(L['a0'] + xa @ L['a2'])
    g = jax.nn.sigmoid(xg) @ L['g2']
    heads = lambda t: t.reshape(B, T, RW_HEADS, RW_HEAD_DIM)
    kk = heads(k * L['k_k']).astype(f32)
    kk = kk / jnp.maximum(jnp.sqrt(jnp.sum(kk * kk, axis=-1, keepdims=True)), 1e-12)
    k = k * (1.0 + (a - 1.0) * L['k_a'])
    rh, kh, vh, ah = heads(r), heads(k), heads(v), heads(a)
    y, S_new = wkv_recurrence(rh, heads(decay), kh, vh, kk, ah, st_wkv)
    mu_ = jnp.mean(y, axis=-1, keepdims=True)
    var = jnp.mean(jnp.square(y - mu_), axis=-1, keepdims=True)
    y = ((y - mu_) * lax.rsqrt(var + GN_EPS)).reshape(B, T, RW_WIDTH)
    y = y * L['lnx_g'].astype(f32) + L['lnx_b'].astype(f32)
    bonus = jnp.sum((rh * kh * L['r_k']).astype(f32), axis=-1, keepdims=True) * vh.astype(f32)
    y = ((y + bonus.reshape(B, T, RW_WIDTH)) * g.astype(f32)).astype(x.dtype)
    rw_out = y @ L['w_rw_out']

    ar, ai, br, bi = s5_discretise(L['A_re'], L['A_im'], L['log_dt'], L['B_re'], L['B_im'])
    ug = u.reshape(B, T, SSM_GROUPS, SSM_GROUP).astype(f32)
    bu_r = jnp.einsum('btgc,gnc->btgn', ug, br)
    bu_i = jnp.einsum('btgc,gnc->btgn', ug, bi)
    x0r, x0i = st_re.astype(f32), st_im.astype(f32)
    bu_r = bu_r.at[:, 0].add(ar * x0r - ai * x0i)
    bu_i = bu_i.at[:, 0].add(ar * x0i + ai * x0r)
    Ar = jnp.broadcast_to(ar, bu_r.shape)
    Ai = jnp.broadcast_to(ai, bu_i.shape)
    _, _, sr, si = lax.associative_scan(complex_affine_combine, (Ar, Ai, bu_r, bu_i), axis=1)
    yc = (jnp.einsum('gcn,btgn->btgc', L['C_re'].astype(f32), sr)
          - jnp.einsum('gcn,btgn->btgc', L['C_im'].astype(f32), si))
    ys = yc.reshape(B, T, SSM_WIDTH) + L['D_skip'].astype(f32) * u.astype(f32)
    z = jax.nn.gelu(ys).astype(x.dtype)
    zz = z @ L['w_glu']
    s5_out = zz[..., :D_MODEL] * jax.nn.sigmoid(zz[..., D_MODEL:])

    g_rw = jax.nn.sigmoid(gate_logits[..., :D_MODEL])
    g_s5 = jax.nn.sigmoid(gate_logits[..., D_MODEL:])
    x = x + ((g_rw * rw_out + g_s5 * s5_out) @ L['w_out']).astype(x.dtype)

    h2 = rmsnorm(x, L['ln2_g'])
    ab = h2 @ L['w_ffn_in']
    a_up, b_up = ab[..., :D_FF], ab[..., D_FF:]
    a_ext = jnp.concatenate([st_conv.astype(a_up.dtype), a_up], axis=1)
    cw = L['conv_w']
    a_conv = (cw[0] * a_ext[:, :T] + cw[1] * a_ext[:, 1:T + 1] + cw[2] * a_ext[:, 2:T + 2]
              + L['conv_b'])
    new_conv = a_ext[:, T:]
    x = x + ((jax.nn.gelu(a_conv) * b_up) @ L['w_ffn_out']).astype(x.dtype)

    pg = jax.nn.sigmoid(rmsnorm(x, L['ln3_g']) @ L['w_ple_gate'])
    x = x + (pg * (p @ L['w_ple'])).astype(x.dtype)
    return x, (new_shift, S_new, sr[:, -1], si[:, -1], new_conv)


def setup_inputs(seed: int = 0) -> dict:
    key = jax.random.key(seed)
    ks = iter(jax.random.split(key, 48))
    f32 = jnp.float32
    nrm = lambda shape, s: jax.random.normal(next(ks), shape, f32) * s
    uni = lambda shape, lo, hi: jax.random.uniform(next(ks), shape, f32, lo, hi)
    Ld = DEPTH
    n_idx = jnp.arange(SSM_STATE, dtype=f32)
    return {
        'x_prompt': nrm((BATCH, SEQ, D_MODEL), 1.0),
        'x_sample': nrm((DEC_BATCH, DEC_SEQ, D_MODEL), 1.0),
        'p_prompt': nrm((DEPTH, BATCH, SEQ, PLE_DIM), 1.0),
        'p_sample': nrm((DEPTH, DEC_BATCH, DEC_SEQ, PLE_DIM), 1.0),
        'state_shift': nrm((DEPTH, DEC_BATCH, SHIFT_WIDTH), 1.0),
        'state_wkv': nrm((DEPTH, DEC_BATCH, RW_HEADS, RW_HEAD_DIM, RW_HEAD_DIM), 0.5),
        'state_ssm_re': nrm((DEPTH, DEC_BATCH, SSM_GROUPS, SSM_STATE), 0.5),
        'state_ssm_im': nrm((DEPTH, DEC_BATCH, SSM_GROUPS, SSM_STATE), 0.5),
        'state_conv': nrm((DEPTH, DEC_BATCH, CONV_W - 1, D_FF), 1.0),
        'ln1_g': 1.0 + nrm((Ld, D_MODEL), 0.02),
        'w_in': nrm((Ld, D_MODEL, IN_WIDTH), D_MODEL ** -0.5),
        'mu_shift': uni((Ld, SHIFT_WIDTH), 0.0, 1.0),
        'w0': uni((Ld, RW_WIDTH), -6.0, 1.0),
        'w2': nrm((Ld, LORA_W, RW_WIDTH), 0.1 * LORA_W ** -0.5),
        'a0': nrm((Ld, RW_WIDTH), 0.1),
        'a2': nrm((Ld, LORA_A, RW_WIDTH), 0.1 * LORA_A ** -0.5),
        'g2': nrm((Ld, LORA_G, RW_WIDTH), LORA_G ** -0.5),
        'k_k': 0.85 + nrm((Ld, RW_WIDTH), 0.02),
        'k_a': 1.0 + nrm((Ld, RW_WIDTH), 0.02),
        'r_k': nrm((Ld, RW_HEADS, RW_HEAD_DIM), 0.1),
        'lnx_g': 1.0 + nrm((Ld, RW_WIDTH), 0.02),
        'lnx_b': nrm((Ld, RW_WIDTH), 0.02),
        'w_rw_out': nrm((Ld, RW_WIDTH, D_MODEL), RW_WIDTH ** -0.5),
        'A_re': -0.5 + nrm((Ld, SSM_GROUPS, SSM_STATE), 0.01),
        'A_im': jnp.pi * n_idx + nrm((Ld, SSM_GROUPS, SSM_STATE), 0.01),
        'log_dt': uni((Ld, SSM_GROUPS), math.log(1e-3), math.log(1e-1)),
        'B_re': nrm((Ld, SSM_GROUPS, SSM_STATE, SSM_GROUP), (2 * SSM_GROUP) ** -0.5),
        'B_im': nrm((Ld, SSM_GROUPS, SSM_STATE, SSM_GROUP), (2 * SSM_GROUP) ** -0.5),
        'C_re': nrm((Ld, SSM_GROUPS, SSM_GROUP, SSM_STATE), (2 * SSM_STATE) ** -0.5),
        'C_im': nrm((Ld, SSM_GROUPS, SSM_GROUP, SSM_STATE), (2 * SSM_STATE) ** -0.5),
        'D_skip': nrm((Ld, SSM_WIDTH), 1.0),
        'w_glu': nrm((Ld, SSM_WIDTH, 2 * D_MODEL), SSM_WIDTH ** -0.5),
        'w_out': nrm((Ld, D_MODEL, D_MODEL), D_MODEL ** -0.5),
        'ln2_g': 1.0 + nrm((Ld, D_MODEL), 0.02),
        'w_ffn_in': nrm((Ld, D_MODEL, 2 * D_FF), D_MODEL ** -0.5),
        'conv_w': nrm((Ld, CONV_W, D_FF), CONV_W ** -0.5),
        'conv_b': nrm((Ld, D_FF), 0.02),
        'w_ffn_out': nrm((Ld, D_FF, D_MODEL), D_FF ** -0.5),
        'ln3_g': 1.0 + nrm((Ld, D_MODEL), 0.02),
        'w_ple_gate': nrm((Ld, D_MODEL, D_MODEL), D_MODEL ** -0.5),
        'w_ple': nrm((Ld, PLE_DIM, D_MODEL), PLE_DIM ** -0.5),
        'final_g': 1.0 + nrm((D_MODEL,), 0.02),
    }


def reference(x_prompt, x_sample, p_prompt, p_sample, state_shift, state_wkv, state_ssm_re,
              state_ssm_im, state_conv, ln1_g, w_in, mu_shift, w0, w2, a0, a2, g2, k_k, k_a,
              r_k, lnx_g, lnx_b, w_rw_out, A_re, A_im, log_dt, B_re, B_im, C_re, C_im, D_skip,
              w_glu, w_out, ln2_g, w_ffn_in, conv_w, conv_b, w_ffn_out, ln3_g, w_ple_gate,
              w_ple, final_g):
    xp, xs = x_prompt, x_sample
    Bp = x_prompt.shape[0]
    pst = [[] for _ in range(5)]
    sst = [[] for _ in range(5)]
    for i in range(DEPTH):
        L = dict(ln1_g=ln1_g[i], w_in=w_in[i], mu_shift=mu_shift[i], w0=w0[i], w2=w2[i],
                 a0=a0[i], a2=a2[i], g2=g2[i], k_k=k_k[i], k_a=k_a[i], r_k=r_k[i],
                 lnx_g=lnx_g[i], lnx_b=lnx_b[i], w_rw_out=w_rw_out[i], A_re=A_re[i],
                 A_im=A_im[i], log_dt=log_dt[i], B_re=B_re[i], B_im=B_im[i], C_re=C_re[i],
                 C_im=C_im[i], D_skip=D_skip[i], w_glu=w_glu[i], w_out=w_out[i],
                 ln2_g=ln2_g[i], w_ffn_in=w_ffn_in[i], conv_w=conv_w[i], conv_b=conv_b[i],
                 w_ffn_out=w_ffn_out[i], ln3_g=ln3_g[i], w_ple_gate=w_ple_gate[i],
                 w_ple=w_ple[i])
        z_shift = jnp.zeros((Bp, SHIFT_WIDTH), xp.dtype)
        z_wkv = jnp.zeros((Bp, RW_HEADS, RW_HEAD_DIM, RW_HEAD_DIM), jnp.float32)
        z_ssm = jnp.zeros((Bp, SSM_GROUPS, SSM_STATE), jnp.float32)
        z_conv = jnp.zeros((Bp, CONV_W - 1, D_FF), xp.dtype)
        xp, sp = layer(xp, p_prompt[i], z_shift, z_wkv, z_ssm, z_ssm, z_conv, L)
        xs, ss = layer(xs, p_sample[i], state_shift[i], state_wkv[i], state_ssm_re[i],
                       state_ssm_im[i], state_conv[i], L)
        for j in range(5):
            pst[j].append(sp[j])
            sst[j].append(ss[j])
    y_prompt = rmsnorm(xp, final_g)
    y_sample = rmsnorm(xs, final_g)
    return (y_prompt, y_sample,
            jnp.stack(pst[0]), jnp.stack(pst[1]), jnp.stack(pst[2]), jnp.stack(pst[3]), jnp.stack(pst[4]),
            jnp.stack(sst[0]), jnp.stack(sst[1]), jnp.stack(sst[2]), jnp.stack(sst[3]), jnp.stack(sst[4]))
```

```cpp
#include <hip/hip_runtime.h>
#include <hip/hip_cooperative_groups.h>
#include <cstdio>
#include <cstdint>
namespace cg = cooperative_groups;

#define LAS __attribute__((address_space(3)))
typedef unsigned short bf16_t;
typedef short bf16x8 __attribute__((ext_vector_type(8)));
typedef float f32x4 __attribute__((ext_vector_type(4)));
typedef float f32x2 __attribute__((ext_vector_type(2)));
typedef unsigned u32x4 __attribute__((ext_vector_type(4)));
typedef unsigned u32x2 __attribute__((ext_vector_type(2)));

constexpr int D = 1024, MP = 16384, MS = 128, MV = MP + MS, M = 16640, T = 2048;
constexpr int INW = 4352, SHW = 1792, DFF = 2816, PLE = 256;
constexpr int COL_U = 1792, COL_G1 = 2304, COL_G2 = 3328;
constexpr float EPS = 1e-6f, GN_EPS = 64e-5f;
constexpr int NWAVES = 8, NT = 512, XCD_BAR_WORDS_C = 3456;
constexpr int Q = 32, NCH = T / Q  , S5R = 8 * NCH  , S5K = Q * 16  , S5P = S5K + 128  ;

constexpr size_t al4k(size_t x) { return (x + 4095) & ~(size_t)4095; }
constexpr size_t WS_WT_IN = 0;
constexpr size_t WS_WT_LORA = al4k(WS_WT_IN + (size_t)INW * D * 2);
constexpr size_t WS_WT_RW = al4k(WS_WT_LORA + (size_t)1536 * 256 * 2);
constexpr size_t WS_WT_GLU = al4k(WS_WT_RW + (size_t)1024 * 512 * 2);
constexpr size_t WS_SMALL = al4k(WS_WT_GLU + (size_t)2048 * 512 * 2);
constexpr size_t SM_RSTD1 = WS_SMALL, SM_SSQ2 = SM_RSTD1 + M * 4, SM_SSQ3 = SM_SSQ2 + M * 4, SM_SSQF = SM_SSQ3 + M * 4, SM_BONUS = SM_SSQF + M * 4;
constexpr size_t SM_SA = al4k(SM_BONUS + (size_t)M * 8 * 4), SM_SB = al4k(SM_SA + (size_t)65 * 4 * DFF * 4);
constexpr size_t SM_BAR = al4k(SM_SB + (size_t)65 * 2 * DFF * 4);
constexpr int CTL_WORDS = 8192 + 64, CW_PANEL = 4096, CW_SKINNY = 8192;
constexpr size_t WS_PBF = al4k(SM_BAR + (size_t)CTL_WORDS * 4);
constexpr size_t WS_S5 = al4k(WS_PBF + (size_t)M * PLE * 2);
constexpr size_t S5_BTY = WS_S5, S5_WSB = al4k(S5_BTY + (size_t)32 * 512 * S5P * 2), S5_U2 = al4k(S5_WSB + (size_t)(32 * 128 + 128) * S5K * 2);
constexpr size_t S5_EE = al4k(S5_U2 + (size_t)32 * S5R * S5P * 2), S5_END = al4k(S5_EE + (size_t)32 * S5R * 128 * 4);
constexpr size_t WS_WT_OUT = WS_WT_IN, WS_WT_FFO = al4k(WS_WT_OUT + (size_t)D * D * 2);
static_assert(WS_WT_FFO + (size_t)D * DFF * 2 <= WS_WT_LORA, "w_out + w_ffn_out fit in WT_IN's space");
constexpr size_t WS_WT_FFI = WS_S5;
constexpr size_t WS_WT_PG = al4k(WS_WT_FFI + (size_t)2 * DFF * D * 2), WS_WT_PLE = al4k(WS_WT_PG + (size_t)D * D * 2), WS_YG = al4k(WS_WT_PLE + (size_t)D * PLE * 2);
constexpr size_t LATE_END = al4k(WS_YG + (size_t)M * 512 * 2);
static_assert(LATE_END <= S5_END, "late overlay fits");
constexpr size_t WS_RA = S5_END;
constexpr size_t WS_PROJ = al4k(WS_RA + (size_t)M * D * 2);
constexpr size_t WS_XB = WS_PROJ, WS_HG = al4k(WS_XB + (size_t)M * D * 2), WS_PE = WS_HG;
constexpr size_t WS_END = al4k(WS_PROJ + (size_t)M * INW * 2);
static_assert(WS_HG + (size_t)M * DFF * 2 <= WS_END && WS_PE + (size_t)M * D * 4 <= WS_END, "overlay");
static_assert(WS_END <= (size_t)256 * 1024 * 1024, "ws budget");
constexpr size_t DO_LO = 0, DO_Z = (size_t)MV * 1536 * 2, DO_T1 = 0;
static_assert(DO_Z + (size_t)MV * 512 * 2 <= (size_t)MV * D * 4, "d_out scratch");
constexpr size_t O_Y = 0, O_PSHIFT = (size_t)MV * D, O_PWKV = O_PSHIFT + 8 * SHW, O_PSRE = O_PWKV + 8 * 8 * 4096, O_PSIM = O_PSRE + 8 * 32 * 64;
constexpr size_t O_PCONV = O_PSIM + 8 * 32 * 64, O_SSHIFT = O_PCONV + 8 * 2 * DFF, O_SWKV = O_SSHIFT + 128 * SHW, O_SSRE = O_SWKV + (size_t)128 * 8 * 4096;
constexpr size_t O_SSIM = O_SSRE + 128 * 32 * 64, O_SCONV = O_SSIM + 128 * 32 * 64, O_END = O_SCONV + 128 * 2 * DFF;

constexpr int REP_P0 = 1, REP_WKV = 1, REP_P1 = 1, REP_P9 = 1, REP_P5 = 1, EXTRA_SYNC = 0;
constexpr int RING_BYTES = 131072, XLDS_OFF = RING_BYTES, LDS_BYTES = 147456;

__device__ __forceinline__ unsigned cvt_pk_bf16(float lo, float hi) { unsigned r; asm("v_cvt_pk_bf16_f32 %0, %1, %2" : "=v"(r) : "v"(lo), "v"(hi)); return r; }
__device__ __forceinline__ u32x4 pack8(f32x4 a, f32x4 b) { u32x4 w; w.x = cvt_pk_bf16(a[0], a[1]); w.y = cvt_pk_bf16(a[2], a[3]); w.z = cvt_pk_bf16(b[0], b[1]); w.w = cvt_pk_bf16(b[2], b[3]); return w; }
__device__ __forceinline__ float bflo(unsigned w) { return __builtin_bit_cast(float, w << 16); }
__device__ __forceinline__ float bfhi(unsigned w) { return __builtin_bit_cast(float, w & 0xffff0000u); }
__device__ __forceinline__ void unpack8(u32x4 w, f32x4& a, f32x4& b) { a = (f32x4){bflo(w.x), bfhi(w.x), bflo(w.y), bfhi(w.y)}; b = (f32x4){bflo(w.z), bfhi(w.z), bflo(w.w), bfhi(w.w)}; }
__device__ __forceinline__ f32x4 unpack4(u32x2 w) { return (f32x4){bflo(w.x), bfhi(w.x), bflo(w.y), bfhi(w.y)}; }
#define LDNT(T, p) __builtin_nontemporal_load((const T*)(p))
__device__ __forceinline__ float bf1(bf16_t h) { return __builtin_bit_cast(float, (unsigned)h << 16); }
__device__ __forceinline__ float fexp(float x) { return __builtin_amdgcn_exp2f(x * 1.4426950408889634f); }
__device__ __forceinline__ float sigm(float x) { return __builtin_amdgcn_rcpf(1.0f + fexp(-x)); }
__device__ __forceinline__ float ftanh(float x) { return 1.0f - 2.0f * __builtin_amdgcn_rcpf(1.0f + fexp(2.0f * x)); }
__device__ __forceinline__ float gelu_t(float x) { const float z = 0.7978845608028654f * (x + 0.044715f * x * x * x); return x * sigm(2.0f * z); }
__device__ __forceinline__ f32x4 sigm4(f32x4 v) {
    const f32x4 a = v * (-1.4426950408889634f);
    f32x4 e; e[0] = __builtin_amdgcn_exp2f(a[0]); e[1] = __builtin_amdgcn_exp2f(a[1]); e[2] = __builtin_amdgcn_exp2f(a[2]); e[3] = __builtin_amdgcn_exp2f(a[3]);
    const f32x4 d = e + 1.0f;
    return (f32x4){__builtin_amdgcn_rcpf(d[0]), __builtin_amdgcn_rcpf(d[1]), __builtin_amdgcn_rcpf(d[2]), __builtin_amdgcn_rcpf(d[3])};
}
__device__ __forceinline__ f32x2 gelu2(f32x2 x) {
    const f32x2 q = (x * x) * (-0.10294324f) + (-2.3022082f); const f32x2 a = x * q;
    f32x2 e; e.x = __builtin_amdgcn_exp2f(a.x); e.y = __builtin_amdgcn_exp2f(a.y);
    const f32x2 d = e + 1.0f; f32x2 r; r.x = __builtin_amdgcn_rcpf(d.x); r.y = __builtin_amdgcn_rcpf(d.y);
    return x * r;
}
__device__ __forceinline__ f32x4 gelu4(f32x4 v) { const f32x2 a = gelu2((f32x2){v[0], v[1]}), b = gelu2((f32x2){v[2], v[3]}); return (f32x4){a.x, a.y, b.x, b.y}; }
__device__ __forceinline__ float wave_sum(float v) {
#pragma unroll
    for (int o = 1; o < 64; o <<= 1) v += __shfl_xor(v, o);
    return v;
}
template <int CTRL> __device__ __forceinline__ float dppf(float x) { return __builtin_bit_cast(float, __builtin_amdgcn_update_dpp(0, __builtin_bit_cast(int, x), CTRL, 0xf, 0xf, true)); }
__device__ __forceinline__ float red16(float x) {
    x += dppf<0xB1>(x); x += dppf<0x4E>(x); x += dppf<0x141>(x); x += dppf<0x140>(x); return x;
}

namespace pg8 {
constexpr int BM = 256, BK = 64, HALF = 128, HTB = HALF * BK * 2, STAGE_BYTES = 8 * HTB;
__host__ __device__ __forceinline__ int lds_byte(int r, int c) { const int st = (r >> 4) * 2 + (c >> 5), rr = r & 15, cc = c & 31, ob = rr * 64 + cc * 2; return st * 1024 + (ob ^ (((ob >> 9) & 1) << 5)); }
__host__ __device__ __forceinline__ void stage_rc(int b, int& R, int& C) { const int st = b / 1024, sb = b % 1024, swz = sb ^ (((sb >> 9) & 1) << 5); R = (st >> 1) * 16 + swz / 64; C = (st & 1) * 32 + (swz % 64) / 2; }
__host__ __device__ __forceinline__ int perm32(int rho) { const int n = rho >> 4, i = rho & 15; return 8 * (i >> 2) + 4 * n + (i & 3); }
struct Unit { int pm, pn, gi; };
constexpr int NXCD = 8, WGM = 8;
__device__ __forceinline__ bool static_tile(int nM, int nN, int G, int c, int i, int& pm, int& pn) {
    const int nwg = nM * nN; const long L = (long)i * G + c; if (L >= nwg) return false;
    int wgid = (int)L; { const int q = nwg / NXCD, r = nwg % NXCD, xcd = wgid % NXCD, off = wgid / NXCD; wgid = (xcd < r ? xcd * (q + 1) : r * (q + 1) + (xcd - r) * q) + off; }
    const int nig = WGM * nN, gid = wgid / nig, fm = gid * WGM, gsz = (nM - fm) < WGM ? (nM - fm) : WGM;
    pm = fm + ((wgid % nig) % gsz); pn = (wgid % nig) / gsz; return true;
}

template <class Epi, class Sched>
__device__ __forceinline__ void gemm_phase(LAS unsigned char* lds, const int K, const int lda, const int ldb, const Sched& S, const Epi& E) {
    int tid = threadIdx.x; asm volatile("" : "+v"(tid));
    const int wid = __builtin_amdgcn_readfirstlane(tid >> 6), lane = tid & 63, wr = wid >> 2, wc = wid & 3, fr = lane & 15, fq = lane >> 4;
    const int nt = K / BK;
    unsigned voffA[2], voffB[2];
#pragma unroll
    for (int i = 0; i < 2; ++i) { int R, C; stage_rc(tid * 16 + i * 8192, R, C); const int Rb = (R & ~31) + perm32(R & 31);
        voffA[i] = (unsigned)(R * lda + C) * 2u; voffB[i] = (unsigned)(Rb * ldb + C) * 2u; }
    const size_t kstep = (size_t)(BK * 2);
    const size_t hstepA = (size_t)HALF * lda * 2, hstepB = (size_t)HALF * ldb * 2;
    const unsigned ldsw = (unsigned)wid * 1024u;
    const int aoff = lds_byte(wr * 64 + fr, fq * 8), boff = lds_byte(wc * 32 + fr, fq * 8);
#define PG8_SA(b, h) (((b) * 2 + (h)) * HTB)
#define PG8_SB(b, h) ((4 + (b) * 2 + (h)) * HTB)
#define PG8_STAGE(bufoff, gbase, voff) do { _Pragma("unroll") for (int _i = 0; _i < 2; ++_i) \
        __builtin_amdgcn_global_load_lds((const unsigned*)((const char*)(gbase) + (voff)[_i]), (LAS unsigned*)(lds + (bufoff) + ldsw + _i * 8192), 16, 0, 0); } while (0)
#define PG8_LDA(dst, b, h) do { _Pragma("unroll") for (int m = 0; m < 4; ++m) _Pragma("unroll") for (int k = 0; k < 2; ++k) dst[m][k] = *(const LAS bf16x8*)(lds + PG8_SA(b, h) + aoff + m * 2048 + k * 1024); } while (0)
#define PG8_LDB(dst, b, h) do { _Pragma("unroll") for (int n = 0; n < 2; ++n) _Pragma("unroll") for (int k = 0; k < 2; ++k) dst[n][k] = *(const LAS bf16x8*)(lds + PG8_SB(b, h) + boff + n * 2048 + k * 1024); } while (0)
#define PG8_MMA(ai, bj, At, Bt) do { __builtin_amdgcn_s_setprio(1); _Pragma("unroll") for (int m = 0; m < 4; ++m) _Pragma("unroll") for (int n = 0; n < 2; ++n) _Pragma("unroll") for (int k = 0; k < 2; ++k) \
        acc[ai][bj][m][n] = __builtin_amdgcn_mfma_f32_16x16x32_bf16(Bt[n][k], At[m][k], acc[ai][bj][m][n], 0, 0, 0); __builtin_amdgcn_s_setprio(0); } while (0)
#define PG8_WAIT_V(n) asm volatile("s_waitcnt vmcnt(" #n ")" ::: "memory")
#define PG8_WAIT_L(n) asm volatile("s_waitcnt lgkmcnt(" #n ")" ::: "memory")
#define PG8_BAR __builtin_amdgcn_s_barrier()
#define PG8_SCHED __builtin_amdgcn_sched_barrier(0)
    Unit cur, nxt; int ui = 0;
    if (!S.next(0, cur)) return;
    f32x4 acc[2][2][4][2];
#pragma unroll
    for (int a = 0; a < 2; ++a)
#pragma unroll
        for (int b = 0; b < 2; ++b)
#pragma unroll
            for (int m = 0; m < 4; ++m)
#pragma unroll
                for (int n = 0; n < 2; ++n) acc[a][b][m][n] = (f32x4){0.f, 0.f, 0.f, 0.f};
    bf16x8 At[4][2], B0[2][2], B1[2][2];
    const char* cA; const char* cB; S.ptrs(cur, cA, cB);
    PG8_STAGE(PG8_SB(0, 0), cB, voffB); PG8_STAGE(PG8_SB(0, 1), cB + hstepB, voffB); PG8_STAGE(PG8_SA(0, 0), cA, voffA); PG8_STAGE(PG8_SA(0, 1), cA + hstepA, voffA);
    if (wr == 1) PG8_BAR;
    PG8_WAIT_V(2); PG8_BAR;
    PG8_STAGE(PG8_SB(1, 0), cB + kstep, voffB); PG8_STAGE(PG8_SA(1, 0), cA + kstep, voffA); PG8_STAGE(PG8_SB(1, 1), cB + hstepB + kstep, voffB);
    PG8_WAIT_V(6); PG8_BAR;
    for (;;) {
        const bool has_next = S.next(ui + 1, nxt);
        const char* nA = cA; const char* nB = cB; if (has_next) S.ptrs(nxt, nA, nB);
        for (int t = 0; t < nt; t += 2) {
            const bool last = (t == nt - 2);
            const char* a1 = cA + (size_t)(t + 1) * kstep;
            const char* a2 = last ? nA : cA + (size_t)(t + 2) * kstep; const char* b2 = last ? nB : cB + (size_t)(t + 2) * kstep;
            const char* a3 = a2 + kstep; const char* b3 = b2 + kstep;
            PG8_LDB(B0, 0, 0); PG8_LDB(B1, 0, 1); PG8_SCHED; PG8_LDA(At, 0, 0); PG8_STAGE(PG8_SA(1, 1), a1 + hstepA, voffA);
            PG8_WAIT_V(8); PG8_WAIT_L(0); PG8_BAR; PG8_MMA(0, 0, At, B0); PG8_MMA(0, 1, At, B1); PG8_BAR; PG8_SCHED;
            PG8_LDA(At, 0, 1); PG8_STAGE(PG8_SB(0, 0), b2, voffB); PG8_STAGE(PG8_SB(0, 1), b2 + hstepB, voffB); PG8_STAGE(PG8_SA(0, 0), a2, voffA);
            PG8_WAIT_V(8); PG8_WAIT_L(0); PG8_BAR; PG8_MMA(1, 0, At, B0); PG8_MMA(1, 1, At, B1); PG8_BAR; PG8_SCHED;
            PG8_LDB(B0, 1, 0); PG8_LDB(B1, 1, 1); PG8_SCHED; PG8_LDA(At, 1, 0); PG8_STAGE(PG8_SA(0, 1), a2 + hstepA, voffA);
            PG8_WAIT_V(8); PG8_WAIT_L(0); PG8_BAR; PG8_MMA(0, 0, At, B0); PG8_MMA(0, 1, At, B1); PG8_BAR; PG8_SCHED;
            PG8_LDA(At, 1, 1); PG8_STAGE(PG8_SB(1, 0), b3, voffB); PG8_STAGE(PG8_SB(1, 1), b3 + hstepB, voffB); PG8_STAGE(PG8_SA(1, 0), a3, voffA);
            PG8_WAIT_V(8); PG8_WAIT_L(0); PG8_BAR; PG8_MMA(1, 0, At, B0); PG8_MMA(1, 1, At, B1); PG8_BAR; PG8_SCHED;
        }
        if (wr == 0) PG8_BAR;
        E(acc, cur, wr, wc, fr, fq);
        if (!has_next) break;
#pragma unroll
        for (int a = 0; a < 2; ++a)
#pragma unroll
            for (int b = 0; b < 2; ++b)
#pragma unroll
                for (int m = 0; m < 4; ++m)
#pragma unroll
                    for (int n = 0; n < 2; ++n) acc[a][b][m][n] = (f32x4){0.f, 0.f, 0.f, 0.f};
        cur = nxt; cA = nA; cB = nB; ++ui;
        if (wr == 1) PG8_BAR;
    }
    PG8_WAIT_V(0);
    PG8_BAR;
#undef PG8_SA
#undef PG8_SB
#undef PG8_STAGE
#undef PG8_LDA
#undef PG8_LDB
#undef PG8_MMA
#undef PG8_WAIT_V
#undef PG8_WAIT_L
#undef PG8_BAR
#undef PG8_SCHED
}
}
using pg8::Unit;
typedef f32x4 Acc[2][2][4][2];

struct SchedStatic {
    const bf16_t* A; const bf16_t* Bt; int lda, ldb, nM, nN, G, c;
    __device__ __forceinline__ bool next(int i, Unit& u) const { u.gi = 0; return pg8::static_tile(nM, nN, G, c, i, u.pm, u.pn); }
    __device__ __forceinline__ void ptrs(const Unit& u, const char*& a, const char*& b) const { a = (const char*)(A + (size_t)u.pm * 256 * lda); b = (const char*)(Bt + (size_t)u.pn * 256 * ldb); }
};
struct SchedGluRw {
    const bf16_t* Z; const bf16_t* YG; const bf16_t* WG; const bf16_t* WR; int nM, G, c;
    __device__ __forceinline__ bool next(int i, Unit& u) const { int pm, pn; if (!pg8::static_tile(nM, 4, G, c, i / 3, pm, pn)) return false; const int s = i % 3; u.pm = pm; u.gi = (s == 2) ? 1 : 0; u.pn = (s == 2) ? pn : 2 * pn + s; return true; }
    __device__ __forceinline__ void ptrs(const Unit& u, const char*& a, const char*& b) const {
        a = (const char*)((u.gi ? YG : Z) + (size_t)u.pm * 256 * 512); b = (const char*)((u.gi ? WR : WG) + (size_t)u.pn * 256 * 512); }
};
struct SchedS5 {
    const bf16_t* A; const bf16_t* Bt; size_t bstride; int ldb, nN, G, c;
    __device__ __forceinline__ bool next(int i, Unit& u) const { const int L = i * G + c; if (L >= 32 * 2 * nN) return false; u.pn = L % nN; const int r = L / nN; u.pm = r & 1; u.gi = r >> 1; return true; }
    __device__ __forceinline__ void ptrs(const Unit& u, const char*& a, const char*& b) const { a = (const char*)(A + ((size_t)u.gi * S5R + (size_t)u.pm * 256) * S5P); b = (const char*)(Bt + (size_t)u.gi * bstride + (size_t)u.pn * 256 * ldb); }
};

#define EPI_ROWLOOP for (int ai = 0; ai < 2; ++ai) _Pragma("unroll") for (int m = 0; m < 4; ++m)
struct EpiProj {
    bf16_t* proj; const float* rstd1; bf16_t* U2;
    __device__ __forceinline__ void operator()(const Acc& acc, const Unit& u, int wr, int wc, int fr, int fq) const {
        const int colb = u.pn * 256 + wc * 32 + 8 * fq;
        float rs[8];
#pragma unroll
        for (int i = 0; i < 8; ++i) rs[i] = rstd1[u.pm * 256 + (i >> 2) * 128 + wr * 64 + (i & 3) * 16 + fr];
#pragma unroll
        EPI_ROWLOOP { const int row = u.pm * 256 + ai * 128 + wr * 64 + m * 16 + fr; const float r1 = rs[ai * 4 + m];
#pragma unroll
            for (int bj = 0; bj < 2; ++bj) { const int col = colb + bj * 128; const u32x4 w = pack8(acc[ai][bj][m][0] * r1, acc[ai][bj][m][1] * r1);
                if (col >= COL_U && col < COL_G1 && row < MP) { const int g = (col - COL_U) >> 4, c0 = (col - COL_U) & 15, b = row >> 11, t = row & 2047;
                    *(u32x4*)(U2 + ((size_t)g * S5R + b * NCH + (t >> 5)) * S5P + (t & 31) * 16 + c0) = w; }
                else *(u32x4*)(proj + (size_t)row * INW + col) = w; } }
    }
};
struct EpiBf {
    bf16_t* O; int ldc;
    __device__ __forceinline__ void operator()(const Acc& acc, const Unit& u, int wr, int wc, int fr, int fq) const {
        const int colb = u.pn * 256 + wc * 32 + 8 * fq;
#pragma unroll
        EPI_ROWLOOP { const int row = u.pm * 256 + ai * 128 + wr * 64 + m * 16 + fr; if (row < MV) {
#pragma unroll
            for (int bj = 0; bj < 2; ++bj) *(u32x4*)(O + (size_t)row * ldc + colb + bj * 128) = pack8(acc[ai][bj][m][0], acc[ai][bj][m][1]); } }
    }
};
struct EpiLora {
    bf16_t* O; const float* w0; const float* a0;
    __device__ __forceinline__ void operator()(const Acc& acc, const Unit& u, int wr, int wc, int fr, int fq) const {
        const int colb = u.pn * 256 + wc * 32 + 8 * fq;
#pragma unroll
        EPI_ROWLOOP { const int row = u.pm * 256 + ai * 128 + wr * 64 + m * 16 + fr; if (row < MV) {
#pragma unroll
            for (int bj = 0; bj < 2; ++bj) { const int col = colb + bj * 128; f32x4 v0 = acc[ai][bj][m][0], v1 = acc[ai][bj][m][1];
                if (col < 512) { v0 = sigm4(v0 + *(const f32x4*)(w0 + col)) * 0.6065306597126334f; v1 = sigm4(v1 + *(const f32x4*)(w0 + col + 4)) * 0.6065306597126334f; }
                else if (col < 1024) { v0 = sigm4(v0 + *(const f32x4*)(a0 + col - 512)); v1 = sigm4(v1 + *(const f32x4*)(a0 + col - 508)); }
                *(u32x4*)(O + (size_t)row * 1536 + col) = pack8(v0, v1); } } }
    }
};
struct EpiS5E {
    float* EE;
    __device__ __forceinline__ void operator()(const Acc& acc, const Unit& u, int wr, int wc, int fr, int fq) const {
        const int col = wc * 32 + 8 * fq;
#pragma unroll
        EPI_ROWLOOP { const int row = u.pm * 256 + ai * 128 + wr * 64 + m * 16 + fr; float* o = EE + ((size_t)u.gi * S5R + row) * 128 + col;
            *(f32x4*)o = acc[ai][0][m][0]; *(f32x4*)(o + 4) = acc[ai][0][m][1]; }
    }
};
struct EpiS5Y {
    bf16_t* Z; const bf16_t* U2; const float* Dsk;
    __device__ __forceinline__ void operator()(const Acc& acc, const Unit& u, int wr, int wc, int fr, int fq) const {
        const int g = u.gi;
        u32x4 pre[8][2]; f32x4 d0[2], d1[2];
#pragma unroll
        for (int bj = 0; bj < 2; ++bj) { const int col = u.pn * 256 + bj * 128 + wc * 32 + 8 * fq, c0 = col & 15; d0[bj] = *(const f32x4*)(Dsk + g * 16 + c0); d1[bj] = *(const f32x4*)(Dsk + g * 16 + c0 + 4);
#pragma unroll
            for (int i = 0; i < 8; ++i) { const int row = u.pm * 256 + (i >> 2) * 128 + wr * 64 + (i & 3) * 16 + fr; pre[i][bj] = *(const u32x4*)(U2 + ((size_t)g * S5R + row) * S5P + col); } }
#pragma unroll
        EPI_ROWLOOP { const int row = u.pm * 256 + ai * 128 + wr * 64 + m * 16 + fr; const int b = row >> 6, ch = row & 63;
#pragma unroll
            for (int bj = 0; bj < 2; ++bj) { const int col = u.pn * 256 + bj * 128 + wc * 32 + 8 * fq; const int t = col >> 4, c0 = col & 15;
                f32x4 u0, u1; unpack8(pre[ai * 4 + m][bj], u0, u1);
                const f32x4 y0 = gelu4(acc[ai][bj][m][0] + d0[bj] * u0), y1 = gelu4(acc[ai][bj][m][1] + d1[bj] * u1);
                *(u32x4*)(Z + ((size_t)(b * T + ch * Q + t)) * 512 + g * 16 + c0) = pack8(y0, y1); } }
    }
};
struct EpiGluRw {
    bf16_t* T1; bf16_t* MG; const bf16_t* proj;
    __device__ __forceinline__ void operator()(const Acc& acc, const Unit& u, int wr, int wc, int fr, int fq) const {
        if (u.gi == 0) { const int col = u.pn * 128 + wc * 32 + 8 * fq;
#pragma unroll
            EPI_ROWLOOP { const int row = u.pm * 256 + ai * 128 + wr * 64 + m * 16 + fr;
                f32x4 g0, g1; unpack8(LDNT(u32x4, proj + (size_t)row * INW + COL_G2 + col), g0, g1);
                const f32x4 s0 = sigm4(g0) * acc[ai][0][m][0] * sigm4(acc[ai][1][m][0]), s1 = sigm4(g1) * acc[ai][0][m][1] * sigm4(acc[ai][1][m][1]);
                *(u32x4*)(T1 + (size_t)row * D + col) = pack8(s0, s1); }
        } else {
#pragma unroll
            EPI_ROWLOOP { const int row = u.pm * 256 + ai * 128 + wr * 64 + m * 16 + fr;
#pragma unroll
                for (int bj = 0; bj < 2; ++bj) { const int col = u.pn * 256 + bj * 128 + wc * 32 + 8 * fq;
                    f32x4 g0, g1, t0, t1; unpack8(LDNT(u32x4, proj + (size_t)row * INW + COL_G1 + col), g0, g1); unpack8(*(const u32x4*)(T1 + (size_t)row * D + col), t0, t1);
                    *(u32x4*)(MG + (size_t)row * D + col) = pack8(sigm4(g0) * acc[ai][bj][m][0] + t0, sigm4(g1) * acc[ai][bj][m][1] + t1); } }
        }
    }
};
__device__ __forceinline__ float sq4(f32x4 v) { return (v[0] * v[0] + v[1] * v[1]) + (v[2] * v[2] + v[3] * v[3]); }
struct EpiRes1 {
    const float* xp; const float* xs; bf16_t* XB; float* ssq;
    __device__ __forceinline__ void operator()(const Acc& acc, const Unit& u, int wr, int wc, int fr, int fq) const {
#pragma unroll
        for (int ai = 0; ai < 2; ++ai) { f32x4 px[4][2][2];
#pragma unroll
            for (int m = 0; m < 4; ++m) { const float* src = xp + (size_t)(u.pm * 256 + ai * 128 + wr * 64 + m * 16 + fr) * D;
#pragma unroll
                for (int bj = 0; bj < 2; ++bj) { const int col = u.pn * 256 + bj * 128 + wc * 32 + 8 * fq; px[m][bj][0] = LDNT(f32x4, src + col); px[m][bj][1] = LDNT(f32x4, src + col + 4); } }
            float sm[4];
#pragma unroll
            for (int m = 0; m < 4; ++m) { const int row = u.pm * 256 + ai * 128 + wr * 64 + m * 16 + fr; float s = 0.f;
#pragma unroll
                for (int bj = 0; bj < 2; ++bj) { const int col = u.pn * 256 + bj * 128 + wc * 32 + 8 * fq;
                    const f32x4 v0 = px[m][bj][0] + acc[ai][bj][m][0], v1 = px[m][bj][1] + acc[ai][bj][m][1];
                    *(u32x4*)(XB + (size_t)row * D + col) = pack8(v0, v1); s += sq4(v0) + sq4(v1); }
                s += __shfl_xor(s, 16); s += __shfl_xor(s, 32); sm[m] = s; }
            atomicAdd(ssq + u.pm * 256 + ai * 128 + wr * 64 + fq * 16 + fr, fq == 0 ? sm[0] : fq == 1 ? sm[1] : fq == 2 ? sm[2] : sm[3]); }
    }
};
struct EpiRes2 {
    bf16_t* XB; float* ssq;
    __device__ __forceinline__ void operator()(const Acc& acc, const Unit& u, int wr, int wc, int fr, int fq) const {
        u32x4 pre[8][2];
#pragma unroll
        for (int i = 0; i < 8; ++i)
#pragma unroll
            for (int bj = 0; bj < 2; ++bj) pre[i][bj] = *(const u32x4*)(XB + (size_t)(u.pm * 256 + (i >> 2) * 128 + wr * 64 + (i & 3) * 16 + fr) * D + u.pn * 256 + bj * 128 + wc * 32 + 8 * fq);
#pragma unroll
        for (int ai = 0; ai < 2; ++ai) { float sm[4];
#pragma unroll
            for (int m = 0; m < 4; ++m) { const int row = u.pm * 256 + ai * 128 + wr * 64 + m * 16 + fr; float s = 0.f;
#pragma unroll
                for (int bj = 0; bj < 2; ++bj) { const int col = u.pn * 256 + bj * 128 + wc * 32 + 8 * fq;
                    f32x4 x0, x1; unpack8(pre[ai * 4 + m][bj], x0, x1);
                    const f32x4 v0 = x0 + acc[ai][bj][m][0], v1 = x1 + acc[ai][bj][m][1];
                    *(u32x4*)(XB + (size_t)row * D + col) = pack8(v0, v1); s += sq4(v0) + sq4(v1); }
                s += __shfl_xor(s, 16); s += __shfl_xor(s, 32); sm[m] = s; }
            atomicAdd(ssq + u.pm * 256 + ai * 128 + wr * 64 + fq * 16 + fr, fq == 0 ? sm[0] : fq == 1 ? sm[1] : fq == 2 ? sm[2] : sm[3]); }
    }
};
struct EpiF32 {
    float* O;
    __device__ __forceinline__ void operator()(const Acc& acc, const Unit& u, int wr, int wc, int fr, int fq) const {
#pragma unroll
        EPI_ROWLOOP { const int row = u.pm * 256 + ai * 128 + wr * 64 + m * 16 + fr;
#pragma unroll
            for (int bj = 0; bj < 2; ++bj) { float* o = O + (size_t)row * D + u.pn * 256 + bj * 128 + wc * 32 + 8 * fq; *(f32x4*)o = acc[ai][bj][m][0]; *(f32x4*)(o + 4) = acc[ai][bj][m][1]; } }
    }
};
struct EpiPle {
    float* X; const float* PE; const float* ssq3; float* ssqF;
    __device__ __forceinline__ void operator()(const Acc& acc, const Unit& u, int wr, int wc, int fr, int fq) const {
#pragma unroll
        EPI_ROWLOOP { const int row = u.pm * 256 + ai * 128 + wr * 64 + m * 16 + fr; float s = 0.f;
            if (row < MV) { const float rs = __builtin_amdgcn_rsqf(ssq3[row] * (1.0f / D) + EPS);
#pragma unroll
                for (int bj = 0; bj < 2; ++bj) { const int col = u.pn * 256 + bj * 128 + wc * 32 + 8 * fq; float* xr = X + (size_t)row * D + col; const float* pe = PE + (size_t)row * D + col;
                    const f32x4 v0 = *(const f32x4*)xr + sigm4(acc[ai][bj][m][0] * rs) * *(const f32x4*)pe, v1 = *(const f32x4*)(xr + 4) + sigm4(acc[ai][bj][m][1] * rs) * *(const f32x4*)(pe + 4);
                    *(f32x4*)xr = v0; *(f32x4*)(xr + 4) = v1; s += sq4(v0) + sq4(v1); } }
            s += __shfl_xor(s, 16); s += __shfl_xor(s, 32); if (fq == 0 && row < MV) atomicAdd(ssqF + row, s); }
    }
};
struct EpiPleFinal {
    float* X; const bf16_t* XB_; const bf16_t* PEB_; const float* ssq3; float* ssqF; unsigned* cnt; const float* fg;
    __device__ __forceinline__ void operator()(Acc& acc, const Unit& u, int wr, int wc, int fr, int fq) const {
        float rs3[8];
#pragma unroll
        for (int i = 0; i < 8; ++i) rs3[i] = ssq3[u.pm * 256 + (i >> 2) * 128 + wr * 64 + (i & 3) * 16 + fr];
#pragma unroll
        for (int ai = 0; ai < 2; ++ai) { u32x4 pp[4][2], px[4][2];
#pragma unroll
            for (int m = 0; m < 4; ++m) { const int row = u.pm * 256 + ai * 128 + wr * 64 + m * 16 + fr;
#pragma unroll
                for (int bj = 0; bj < 2; ++bj) { const int col = u.pn * 256 + bj * 128 + wc * 32 + 8 * fq; pp[m][bj] = LDNT(u32x4, PEB_ + (size_t)row * D + col); px[m][bj] = LDNT(u32x4, XB_ + (size_t)row * D + col); } }
            float sm[4];
#pragma unroll
            for (int m = 0; m < 4; ++m) { float s = 0.f; const float rs = __builtin_amdgcn_rsqf(rs3[ai * 4 + m] * (1.0f / D) + EPS);
#pragma unroll
                for (int bj = 0; bj < 2; ++bj) {
                    f32x4 p0, p1, x0, x1; unpack8(pp[m][bj], p0, p1); unpack8(px[m][bj], x0, x1);
                    const f32x4 v0 = x0 + sigm4(acc[ai][bj][m][0] * rs) * p0, v1 = x1 + sigm4(acc[ai][bj][m][1] * rs) * p1;
                    acc[ai][bj][m][0] = v0; acc[ai][bj][m][1] = v1; s += sq4(v0) + sq4(v1); }
                s += __shfl_xor(s, 16); s += __shfl_xor(s, 32); sm[m] = s; }
            atomicAdd(ssqF + u.pm * 256 + ai * 128 + wr * 64 + fq * 16 + fr, fq == 0 ? sm[0] : fq == 1 ? sm[1] : fq == 2 ? sm[2] : sm[3]); }
        asm volatile("s_waitcnt vmcnt(0)" ::: "memory"); __builtin_amdgcn_s_barrier(); asm volatile("" ::: "memory");
        if (threadIdx.x == 0) { unsigned* c = cnt + 64 * u.pm; __hip_atomic_fetch_add(c, 1u, __ATOMIC_RELAXED, __HIP_MEMORY_SCOPE_AGENT);
            unsigned sp = 0; while (__hip_atomic_load(c, __ATOMIC_RELAXED, __HIP_MEMORY_SCOPE_AGENT) < 4u) { __builtin_amdgcn_s_sleep(1); if (++sp > (1u << 20)) break; } }
        asm volatile("s_waitcnt vmcnt(0) lgkmcnt(0)" ::: "memory"); __builtin_amdgcn_s_barrier(); asm volatile("" ::: "memory");
        { float rsf[8]; f32x4 g0[2], g1[2];
#pragma unroll
          for (int i = 0; i < 8; ++i) rsf[i] = __hip_atomic_load(ssqF + u.pm * 256 + (i >> 2) * 128 + wr * 64 + (i & 3) * 16 + fr, __ATOMIC_RELAXED, __HIP_MEMORY_SCOPE_AGENT);
#pragma unroll
          for (int bj = 0; bj < 2; ++bj) { const int col = u.pn * 256 + bj * 128 + wc * 32 + 8 * fq; g0[bj] = *(const f32x4*)(fg + col); g1[bj] = *(const f32x4*)(fg + col + 4); }
#pragma unroll
          EPI_ROWLOOP { const int row = u.pm * 256 + ai * 128 + wr * 64 + m * 16 + fr; const float rs = __builtin_amdgcn_rsqf(rsf[ai * 4 + m] * (1.0f / D) + EPS);
#pragma unroll
            for (int bj = 0; bj < 2; ++bj) { const int col = u.pn * 256 + bj * 128 + wc * 32 + 8 * fq; float* xr = X + (size_t)row * D + col;
                *(f32x4*)xr = acc[ai][bj][m][0] * rs * g0[bj]; *(f32x4*)(xr + 4) = acc[ai][bj][m][1] * rs * g1[bj]; } } }
    }
};
struct SchedTail {
    const bf16_t* A; const bf16_t* Bt; int lda, ldb, first, nidle, nunits, nN, c;
    __device__ __forceinline__ bool next(int i, Unit& u) const { if (c < first) return false; const int L = i * nidle + (c - first); if (L >= nunits) return false; u.pm = L / nN; u.pn = L % nN; u.gi = 0; return true; }
    __device__ __forceinline__ void ptrs(const Unit& u, const char*& a, const char*& b) const { a = (const char*)(A + (size_t)u.pm * 256 * lda); b = (const char*)(Bt + (size_t)u.pn * 256 * ldb); }
};
struct EpiFfn {
    bf16_t* HG; const float* ssq2; const float* cw; const float* cb; float* SA; float* SB; const float* stc; float* out; LAS float* halo;
    __device__ __forceinline__ void operator()(Acc& acc, const Unit& u, int wr, int wc, int fr, int fq) const {
        const int cl = wc * 32 + 8 * fq, col = u.pn * 128 + cl;
#pragma unroll
        EPI_ROWLOOP { const int row = u.pm * 256 + ai * 128 + wr * 64 + m * 16 + fr; const float rs = __builtin_amdgcn_rsqf(ssq2[row < MV ? row : 0] * (1.0f / D) + EPS);
#pragma unroll
            for (int bj = 0; bj < 2; ++bj) { acc[ai][bj][m][0] *= rs; acc[ai][bj][m][1] *= rs; } }
        if (u.pm == 64) {
#pragma unroll
            for (int m = 0; m < 4; ++m) { const int r = wr * 64 + m * 16 + fr;
#pragma unroll
                for (int n = 0; n < 2; ++n) { const int c4 = col + 4 * n; const float* s0 = stc + ((size_t)r * 2) * DFF + c4;
                    const f32x4 p2 = *(const f32x4*)s0, p1 = *(const f32x4*)(s0 + DFF), a0 = acc[0][0][m][n];
                    const f32x4 cv = *(const f32x4*)(cw + c4) * p2 + *(const f32x4*)(cw + DFF + c4) * p1 + *(const f32x4*)(cw + 2 * DFF + c4) * a0 + *(const f32x4*)(cb + c4);
                    const f32x4 hv = gelu4(cv) * acc[0][1][m][n]; u32x2 w; w.x = cvt_pk_bf16(hv[0], hv[1]); w.y = cvt_pk_bf16(hv[2], hv[3]);
                    *(u32x2*)(HG + (size_t)(MP + r) * DFF + c4) = w;
                    float* o = out + O_SCONV + ((size_t)r * 2) * DFF + c4; *(f32x4*)o = p1; *(f32x4*)(o + DFF) = a0; }
                asm volatile("" ::: "memory"); }
            __builtin_amdgcn_s_barrier();
            return;
        }
#pragma unroll
        for (int ai = 0; ai < 2; ++ai) if (fr >= 14) { LAS float* h = halo + ((2 * ai + wr) * 2 + (fr - 14)) * 128 + cl; *(LAS f32x4*)h = acc[ai][0][3][0]; *(LAS f32x4*)(h + 4) = acc[ai][0][3][1]; }
        if (wr == 0 && fr < 2) { float* s = SA + ((size_t)u.pm * 4 + fr) * DFF + col; *(f32x4*)s = acc[0][0][0][0]; *(f32x4*)(s + 4) = acc[0][0][0][1];
            float* sb = SB + ((size_t)u.pm * 2 + fr) * DFF + col; *(f32x4*)sb = acc[0][1][0][0]; *(f32x4*)(sb + 4) = acc[0][1][0][1]; }
        if (wr == 1 && fr >= 14) { float* s = SA + ((size_t)u.pm * 4 + 2 + (fr - 14)) * DFF + col; *(f32x4*)s = acc[1][0][3][0]; *(f32x4*)(s + 4) = acc[1][0][3][1];
            if ((u.pm & 7) == 7) { float* o = out + O_PCONV + ((size_t)(u.pm >> 3) * 2 + (fr - 14)) * DFF + col; *(f32x4*)o = acc[1][0][3][0]; *(f32x4*)(o + 4) = acc[1][0][3][1]; } }
        asm volatile("s_waitcnt lgkmcnt(0)" ::: "memory"); __builtin_amdgcn_s_barrier(); asm volatile("" ::: "memory");
        const int loff = fr * DFF + col;
#pragma unroll
        for (int ai = 0; ai < 2; ++ai) { const int seg = 2 * ai + wr;
#pragma unroll
            for (int n = 0; n < 2; ++n) { const int c4 = col + 4 * n;
                const f32x4 w0 = *(const f32x4*)(cw + c4), w1 = *(const f32x4*)(cw + DFF + c4), w2 = *(const f32x4*)(cw + 2 * DFF + c4), bb = *(const f32x4*)(cb + c4);
                f32x4 h0 = (f32x4){0.f, 0.f, 0.f, 0.f}, h1 = h0;
                if (seg > 0) { const LAS float* h = halo + ((seg - 1) * 2) * 128 + cl + 4 * n; h0 = *(const LAS f32x4*)h; h1 = *(const LAS f32x4*)(h + 128); }
#pragma unroll
                for (int m = 0; m < 4; ++m) { bf16_t* rowbase = HG + (size_t)(u.pm * 256 + ai * 128 + wr * 64 + m * 16) * DFF + 4 * n;
                    f32x4 cv;
#pragma unroll
                    for (int e = 0; e < 4; ++e) { const float a = acc[ai][0][m][n][e];
                        float q1, q2;
                        if (m > 0) { const float mir = dppf<0x140>(acc[ai][0][m - 1][n][e]); q1 = mir; q2 = dppf<0xB1>(mir); }
                        else { q1 = h1[e]; q2 = fr == 0 ? h0[e] : h1[e]; }
                        const float p1 = __builtin_bit_cast(float, __builtin_amdgcn_update_dpp(__builtin_bit_cast(int, q1), __builtin_bit_cast(int, a), 0x111, 0xf, 0xf, false));
                        const float p2 = __builtin_bit_cast(float, __builtin_amdgcn_update_dpp(__builtin_bit_cast(int, q2), __builtin_bit_cast(int, a), 0x112, 0xf, 0xf, false));
                        cv[e] = w0[e] * p2 + w1[e] * p1 + w2[e] * a + bb[e]; }
                    const f32x4 hv = gelu4(cv) * acc[ai][1][m][n]; u32x2 w; w.x = cvt_pk_bf16(hv[0], hv[1]); w.y = cvt_pk_bf16(hv[2], hv[3]);
                    *(u32x2*)(rowbase + loff) = w; }
                asm volatile("" ::: "memory"); } }
    }
};

#define XB_TMO      128
#define XB_XCNT(j)  (256  + 64 * (j))
#define XB_XSUB(j)  (1280 + 64 * (j))
#define XB_XGEN(j)  (2304 + 64 * (j))
#define XB_TOP      3328
#define XB_TOPGEN   3392
#define XCD_BAR_WORDS 3456
#define XB_SPIN_CAP (1u << 18)
__device__ __forceinline__ unsigned xb_ld(unsigned* p)              { return __hip_atomic_load(p, __ATOMIC_RELAXED, __HIP_MEMORY_SCOPE_AGENT); }
__device__ __forceinline__ unsigned xb_add(unsigned* p, unsigned v) { return __hip_atomic_fetch_add(p, v, __ATOMIC_RELAXED, __HIP_MEMORY_SCOPE_AGENT); }
__device__ __forceinline__ unsigned xb_xcc_id() { return (unsigned)__builtin_amdgcn_s_getreg((3 << 11) | 20) & 0xFu; }
#define XB_SPIN(cond, bar) do { unsigned _sp = 0; while (cond) { __builtin_amdgcn_s_sleep(1); \
    if ((++_sp & 255u) == 0u) { if (xb_ld(&(bar)[XB_TMO])) break; if (_sp > XB_SPIN_CAP) { atomicAdd(&(bar)[XB_TMO], 1u); break; } } } } while (0)
struct XcdBarrier { unsigned* bar; unsigned x; volatile LAS unsigned* st; };
__device__ __forceinline__ void xcd_barrier_complete(unsigned* bar, unsigned x, unsigned& nloc, unsigned& nx) {
    const unsigned G = gridDim.x * gridDim.y * gridDim.z;
    unsigned sum, cnt, mine, sp = 0u;
    for (;;) {
        sum = 0u; cnt = 0u; mine = 0u;
#pragma unroll
        for (unsigned j = 0; j < 16; ++j) { const unsigned c = xb_ld(&bar[XB_XCNT(j)]); sum += c; cnt += (c > 0u) ? 1u : 0u; mine = (j == x) ? c : mine; }
        if (sum == G) break;
        __builtin_amdgcn_s_sleep(1);
        if ((++sp & 255u) == 0u) { if (xb_ld(&bar[XB_TMO])) break; if (sp > XB_SPIN_CAP) { atomicAdd(&bar[XB_TMO], 1u); break; } }
    }
    nloc = mine > 0u ? mine : 1u; nx = cnt > 0u ? cnt : 1u;
}
__device__ __forceinline__ void xcd_barrier(const XcdBarrier& b) {
    asm volatile("s_waitcnt vmcnt(0)" ::: "memory");
    __syncthreads();
    if (threadIdx.x == 0) {
        unsigned* bar = b.bar;
        __builtin_amdgcn_s_waitcnt(0);
        unsigned nloc = b.st[0], nx = b.st[1];
        if (nloc == 0u) { xcd_barrier_complete(bar, b.x, nloc, nx); b.st[0] = nloc; b.st[1] = nx; }
        const unsigned old = xb_add(&bar[XB_XSUB(b.x)], 1u);
        const unsigned gen = old / nloc;
        if (old + 1u == (gen + 1u) * nloc) {
            __builtin_amdgcn_fence(__ATOMIC_RELEASE, "agent");
            asm volatile("s_waitcnt vmcnt(0)" ::: "memory");
            const unsigned og = xb_add(&bar[XB_TOP], 1u);
            const unsigned tg = og / nx;
            if (og + 1u == (tg + 1u) * nx) xb_add(&bar[XB_TOPGEN], 1u);
            else XB_SPIN(xb_ld(&bar[XB_TOPGEN]) == tg, bar);
            __builtin_amdgcn_fence(__ATOMIC_ACQUIRE, "agent");
            xb_add(&bar[XB_XGEN(b.x)], 1u);
            asm volatile("s_waitcnt vmcnt(0)" ::: "memory");
        } else {
            XB_SPIN(xb_ld(&bar[XB_XGEN(b.x)]) == gen, bar);
            __builtin_amdgcn_fence(__ATOMIC_ACQUIRE, "agent");
            asm volatile("s_waitcnt vmcnt(0)" ::: "memory");
        }
    }
    __syncthreads();
}

__device__ __forceinline__ f32x4 skinny_part(const bf16_t* A, int lda, const bf16_t* Bt, int ldb, int k0, int klen, int fr, int fq) {
    const bf16_t* ap = A + (size_t)fr * lda + fq * 8 + k0; const bf16_t* bp = Bt + (size_t)fr * ldb + fq * 8 + k0;
    f32x4 acc = (f32x4){0.f, 0.f, 0.f, 0.f};
#pragma unroll 11
    for (int k = 0; k < klen; k += 32) { const bf16x8 a0 = *(const bf16x8*)(ap + k), b0 = *(const bf16x8*)(bp + k); acc = __builtin_amdgcn_mfma_f32_16x16x32_bf16(b0, a0, acc, 0, 0, 0); }
    return acc;
}
__device__ __forceinline__ void skinny_put(LAS f32x4* red, int slot, int wave, int lane, f32x4 v) { red[(slot * 8 + wave) * 64 + lane] = v; }
__device__ __forceinline__ f32x4 skinny_get(const LAS f32x4* red, int slot, int lane) { f32x4 v = red[(slot * 8) * 64 + lane];
#pragma unroll
    for (int w = 1; w < 8; ++w) v += red[(slot * 8 + w) * 64 + lane];
    return v; }
__device__ __forceinline__ u32x2 pack4(f32x4 v) { u32x2 w; w.x = cvt_pk_bf16(v[0], v[1]); w.y = cvt_pk_bf16(v[2], v[3]); return w; }

struct Args { const float* in[42]; float* out; unsigned char* ws; };
struct Frame {
    LAS unsigned char* lds; int tid, lane, wave, G, c;
    const float* const* in; float* out; unsigned char* ws;
};
typedef const __attribute__((address_space(4))) unsigned long long* KAP;
typedef __attribute__((address_space(1))) unsigned char* GPTR;
#define IN(k) ((const float*)(GPTR)ka[k])
enum { I_XP = 0, I_XS, I_PP, I_PS, I_SSHIFT, I_SWKV, I_SSRE, I_SSIM, I_SCONV, I_LN1, I_WIN, I_MU, I_W0, I_W2, I_A0, I_A2, I_G2, I_KK, I_KA, I_RK, I_LNXG, I_LNXB, I_WRW,
       I_ARE, I_AIM, I_LOGDT, I_BRE, I_BIM, I_CRE, I_CIM, I_DSK, I_WGLU, I_WOUT, I_LN2, I_WFFI, I_CW, I_CB, I_WFFO, I_LN3, I_WPG, I_WPLE, I_FG };

__device__ __forceinline__ void transpose_item(const float* W, const float* g, int K, int N, bf16_t* WT, int ldk, int koff, int row_off, int half, LAS float* scr, int item, int lane) {
    const int nblk = N / 32, kb = item / nblk, nb = item % nblk, k0 = 64 * kb, n0 = 32 * nb;
#pragma unroll 8
    for (int i = 0; i < 32; ++i) { const int kk = 2 * i + (lane >> 5); float v = __builtin_nontemporal_load(&W[(size_t)(k0 + kk) * N + n0 + (lane & 31)]); if (g) v *= g[k0 + kk]; scr[kk * 33 + (lane & 31)] = v; }
    asm volatile("s_waitcnt lgkmcnt(0)" ::: "memory");
    const int c = lane & 7;
    int rbase = row_off + n0;
    if (half > 0) { const int h = n0 / half, np = n0 % half; rbase = (np / 128) * 256 + h * 128 + (np % 128); }
#pragma unroll
    for (int j = 0; j < 4; ++j) { const int n = (lane >> 3) + 8 * j; const LAS float* s = scr + (8 * c) * 33 + n;
        u32x4 o; o.x = cvt_pk_bf16(s[0 * 33], s[1 * 33]); o.y = cvt_pk_bf16(s[2 * 33], s[3 * 33]); o.z = cvt_pk_bf16(s[4 * 33], s[5 * 33]); o.w = cvt_pk_bf16(s[6 * 33], s[7 * 33]);
        *(u32x4*)(WT + (size_t)(rbase + n) * ldk + koff + k0 + 8 * c) = o; }
    asm volatile("s_waitcnt lgkmcnt(0)" ::: "memory");
}

__global__ void __launch_bounds__(NT, 2) fwd(Args args) {
    extern __shared__ __attribute__((aligned(16))) unsigned char lds_raw[];
    LAS unsigned char* lds = (LAS unsigned char*)lds_raw;
#define PH_BEGIN int tid = (int)threadIdx.x; asm volatile("" : "+v"(tid)); const int lane = tid & 63, wave = __builtin_amdgcn_readfirstlane(tid >> 6); \
    int G = gridDim.x; asm volatile("" : "+s"(G)); int cu = blockIdx.x; asm volatile("" : "+s"(cu)); const int NGW = G * NWAVES, NGT = G * NT; (void)NGW; (void)NGT; \
    const int gw = cu * NWAVES + wave, gt = cu * NT + tid; (void)gw; (void)gt; (void)lane; \
    KAP ka = (KAP)__builtin_amdgcn_kernarg_segment_ptr(); asm volatile("" : "+s"(ka)); \
    unsigned char* ws = (unsigned char*)(GPTR)ka[43]; unsigned char* outb = (unsigned char*)(GPTR)ka[42]; float* out = (float*)outb; (void)out;
#define GSYNC() do { KAP ka2 = (KAP)__builtin_amdgcn_kernarg_segment_ptr(); asm volatile("" : "+s"(ka2)); \
    XcdBarrier bb_; bb_.bar = (unsigned*)((unsigned char*)(GPTR)ka2[43] + SM_BAR); bb_.x = xb_xcc_id(); bb_.st = (volatile LAS unsigned*)(lds + XLDS_OFF + 8192); xcd_barrier(bb_); } while (0)
#define WT_IN ((bf16_t*)(ws + WS_WT_IN))
#define WT_LORA ((bf16_t*)(ws + WS_WT_LORA))
#define WT_RW ((bf16_t*)(ws + WS_WT_RW))
#define WT_GLU ((bf16_t*)(ws + WS_WT_GLU))
#define WT_OUT ((bf16_t*)(ws + WS_WT_OUT))
#define WT_FFI ((bf16_t*)(ws + WS_WT_FFI))
#define WT_FFO ((bf16_t*)(ws + WS_WT_FFO))
#define WT_PG ((bf16_t*)(ws + WS_WT_PG))
#define WT_PLE ((bf16_t*)(ws + WS_WT_PLE))
#define RSTD1 ((float*)(ws + SM_RSTD1))
#define SSQ2 ((float*)(ws + SM_SSQ2))
#define SSQ3 ((float*)(ws + SM_SSQ3))
#define SSQF ((float*)(ws + SM_SSQF))
#define BONUS ((float*)(ws + SM_BONUS))
#define SA ((float*)(ws + SM_SA))
#define SB ((float*)(ws + SM_SB))
#define PBF ((bf16_t*)(ws + WS_PBF))
#define BTY ((bf16_t*)(ws + S5_BTY))
#define WSB ((bf16_t*)(ws + S5_WSB))
#define U2 ((bf16_t*)(ws + S5_U2))
#define EE ((float*)(ws + S5_EE))
#define YG ((bf16_t*)(ws + WS_YG))
#define XN ((bf16_t*)(ws + WS_RA))
#define LIN ((bf16_t*)(ws + WS_RA))
#define YWKV ((bf16_t*)(ws + WS_RA))
#define MG ((bf16_t*)(ws + WS_RA))
#define PROJ ((bf16_t*)(ws + WS_PROJ))
#define XB ((bf16_t*)(ws + WS_XB))
#define HG ((bf16_t*)(ws + WS_HG))
#define PEB ((bf16_t*)(ws + WS_RA))
#define LO ((bf16_t*)(outb + DO_LO))
#define ZB ((bf16_t*)(outb + DO_Z))
#define T1 ((bf16_t*)(outb + DO_T1))
#define X out

    if (threadIdx.x < 2) ((volatile LAS unsigned*)(lds + XLDS_OFF + 8192))[threadIdx.x] = 0u;
    { KAP ka2 = (KAP)__builtin_amdgcn_kernarg_segment_ptr(); asm volatile("" : "+s"(ka2)); if (threadIdx.x == 0) (void)xb_add((unsigned*)((unsigned char*)(GPTR)ka2[43] + SM_BAR) + XB_XCNT(xb_xcc_id()), 1u); }
    __syncthreads();
    {
        PH_BEGIN
        for (int rep = 0; rep < REP_P0; ++rep) {
        __syncthreads();
        LAS float* scr = (LAS float*)(lds + wave * 16384);
        constexpr int I_IN = (D / 64) * (INW / 32), I_RWW = (512 / 64) * (D / 32), I_GL = (512 / 64) * (2048 / 32), I_L64 = 16, I_L128 = 32;
        constexpr int NITEMS = I_IN + I_RWW + I_GL + 2 * I_L64 + I_L128;
        for (int it = gw; it < NITEMS; it += NGW) {
            int r = it;
            if (r < I_IN) { transpose_item(IN(I_WIN), IN(I_LN1), D, INW, WT_IN, D, 0, 0, 0, scr, r, lane); continue; } r -= I_IN;
            if (r < I_RWW) { transpose_item(IN(I_WRW), nullptr, 512, D, WT_RW, 512, 0, 0, 0, scr, r, lane); continue; } r -= I_RWW;
            if (r < I_GL) { transpose_item(IN(I_WGLU), nullptr, 512, 2048, WT_GLU, 512, 0, 0, 1024, scr, r, lane); continue; } r -= I_GL;
            if (r < I_L64) { transpose_item(IN(I_W2), nullptr, 64, 512, WT_LORA, 256, 0, 0, 0, scr, r, lane); continue; } r -= I_L64;
            if (r < I_L64) { transpose_item(IN(I_A2), nullptr, 64, 512, WT_LORA, 256, 64, 512, 0, scr, r, lane); continue; } r -= I_L64;
            transpose_item(IN(I_G2), nullptr, 128, 512, WT_LORA, 256, 128, 1024, 0, scr, r, lane);
        }
        for (int i = gt; i < 1536 * 32; i += NGT) { const int n = i >> 5, k = (i & 31) * 8; const bool nz = (n < 512) ? (k < 64) : (n < 1024 ? (k >= 64 && k < 128) : (k >= 128));
            if (!nz) *(u32x4*)(WT_LORA + (size_t)n * 256 + k) = (u32x4){0u, 0u, 0u, 0u}; }
#pragma unroll 2
        for (int m = gw; m < M; m += NGW) {
            u32x2* o = (u32x2*)(XN + (size_t)m * D) + lane;
            if (m < MV) { const float* xr = m < MP ? IN(I_XP) + (size_t)m * D : IN(I_XS) + (size_t)(m - MP) * D; float s = 0.f;
#pragma unroll
                for (int j = 0; j < 4; ++j) { const f32x4 v = LDNT(f32x4, (const f32x4*)xr + lane + 64 * j); s += sq4(v); u32x2 w; w.x = cvt_pk_bf16(v[0], v[1]); w.y = cvt_pk_bf16(v[2], v[3]); o[64 * j] = w; }
                s = wave_sum(s); if (lane == 0) RSTD1[m] = __builtin_amdgcn_rsqf(s * (1.0f / D) + EPS);
                const float* pr = m < MP ? IN(I_PP) + (size_t)m * PLE : IN(I_PS) + (size_t)(m - MP) * PLE; const f32x4 pv = LDNT(f32x4, (const f32x4*)pr + lane);
                u32x2 w; w.x = cvt_pk_bf16(pv[0], pv[1]); w.y = cvt_pk_bf16(pv[2], pv[3]); *((u32x2*)(PBF + (size_t)m * PLE) + lane) = w;
            } else {
#pragma unroll
                for (int j = 0; j < 4; ++j) o[64 * j] = (u32x2){0u, 0u};
                if (lane == 0) RSTD1[m] = 1.0f; *((u32x2*)(PBF + (size_t)m * PLE) + lane) = (u32x2){0u, 0u};
            }
            if (lane == 0) { SSQ2[m] = 0.f; SSQ3[m] = 0.f; SSQF[m] = 0.f; }
        }
        {
            LAS float* Xr = (LAS float*)(lds + wave * 16384); LAS float* Xi = Xr + 1024; LAS float* Kt = Xi + 1024;
            for (int it2 = gw; it2 < 2 * 32 * 32; it2 += NGW) { if (it2 & 1) continue; const int it = it2 >> 1;
                const int g = it >> 5, tau = it & 31, n = lane;
                const float dt = expf(IN(I_LOGDT)[g]); const float lr = IN(I_ARE)[g * 64 + n], li = IN(I_AIM)[g * 64 + n];
                float sn, cs; const float mg = expf(lr * dt * tau); sincosf(li * dt * tau, &sn, &cs); const float pr = mg * cs, pi = mg * sn;
                const float mg1 = expf(lr * dt * (tau + 1)); sincosf(li * dt * (tau + 1), &sn, &cs); const float p1r = mg1 * cs, p1i = mg1 * sn;
                const float m1 = expf(lr * dt); sincosf(li * dt, &sn, &cs); const float ar = m1 * cs, ai = m1 * sn, den = lr * lr + li * li;
                const float fr_ = ((ar - 1.0f) * lr + ai * li) / den, fi_ = (ai * lr - (ar - 1.0f) * li) / den;
                { const float* brp = IN(I_BRE) + (size_t)(g * 64 + n) * 16; const float* bip = IN(I_BIM) + (size_t)(g * 64 + n) * 16; const int sidx = 31 - tau;
                  unsigned wre[8], wim[8];
#pragma unroll
                  for (int c4 = 0; c4 < 4; ++c4) { const f32x4 br = *(const f32x4*)(brp + 4 * c4), bi = *(const f32x4*)(bip + 4 * c4); f32x4 xr, xi;
#pragma unroll
                      for (int e = 0; e < 4; ++e) { const float bbr = fr_ * br[e] - fi_ * bi[e], bbi = fr_ * bi[e] + fi_ * br[e]; xr[e] = pr * bbr - pi * bbi; xi[e] = pr * bbi + pi * bbr; }
                      *(LAS f32x4*)(Xr + n * 16 + 4 * c4) = xr; *(LAS f32x4*)(Xi + n * 16 + 4 * c4) = xi;
                      wre[2 * c4] = cvt_pk_bf16(xr[0], xr[1]); wre[2 * c4 + 1] = cvt_pk_bf16(xr[2], xr[3]); wim[2 * c4] = cvt_pk_bf16(xi[0], xi[1]); wim[2 * c4 + 1] = cvt_pk_bf16(xi[2], xi[3]); }
                  bf16_t* wsr = WSB + ((size_t)g * 128 + n) * S5K + sidx * 16; bf16_t* wsi = wsr + (size_t)64 * S5K;
                  *(u32x4*)wsr = (u32x4){wre[0], wre[1], wre[2], wre[3]}; *(u32x4*)(wsr + 8) = (u32x4){wre[4], wre[5], wre[6], wre[7]};
                  *(u32x4*)wsi = (u32x4){wim[0], wim[1], wim[2], wim[3]}; *(u32x4*)(wsi + 8) = (u32x4){wim[4], wim[5], wim[6], wim[7]}; }
#pragma unroll 4
                for (int c = 0; c < 16; ++c) { const float cr = IN(I_CRE)[(size_t)(g * 16 + c) * 64 + n], ci = IN(I_CIM)[(size_t)(g * 16 + c) * 64 + n];
                    bf16_t* o = BTY + ((size_t)g * 512 + tau * 16 + c) * S5P + 512 + n; const unsigned w = cvt_pk_bf16(cr * p1r - ci * p1i, -(cr * p1i + ci * p1r)); o[0] = (bf16_t)(w & 0xffff); o[64] = (bf16_t)(w >> 16); }
                asm volatile("s_waitcnt lgkmcnt(0)" ::: "memory");
                { const int c = lane >> 2, cq = (lane & 3) * 4; const float* crp = IN(I_CRE) + (size_t)(g * 16 + c) * 64; const float* cip = IN(I_CIM) + (size_t)(g * 16 + c) * 64; f32x4 acc = (f32x4){0.f, 0.f, 0.f, 0.f};
#pragma unroll 4
                  for (int nn = 0; nn < 64; nn += 4) { const f32x4 cr = *(const f32x4*)(crp + nn), ci = *(const f32x4*)(cip + nn);
#pragma unroll
                      for (int e = 0; e < 4; ++e) { const f32x4 xr = *(const LAS f32x4*)(Xr + (nn + e) * 16 + cq), xi = *(const LAS f32x4*)(Xi + (nn + e) * 16 + cq); acc += xr * cr[e] - xi * ci[e]; } }
                  *(LAS f32x4*)(Kt + c * 16 + cq) = acc; }
                asm volatile("s_waitcnt lgkmcnt(0)" ::: "memory");
                for (int idx = lane; idx < (32 - tau) * 32; idx += 64) { const int blk = idx >> 5, rc = (idx & 31) >> 1, hf = idx & 1; const LAS float* kp = Kt + rc * 16 + hf * 8;
                    u32x4 w; w.x = cvt_pk_bf16(kp[0], kp[1]); w.y = cvt_pk_bf16(kp[2], kp[3]); w.z = cvt_pk_bf16(kp[4], kp[5]); w.w = cvt_pk_bf16(kp[6], kp[7]);
                    *(u32x4*)(BTY + ((size_t)g * 512 + (tau + blk) * 16 + rc) * S5P + blk * 16 + hf * 8) = w;
                    if (tau > 0) *(u32x4*)(BTY + ((size_t)g * 512 + blk * 16 + rc) * S5P + (tau + blk) * 16 + hf * 8) = (u32x4){0u, 0u, 0u, 0u}; }
                asm volatile("s_waitcnt lgkmcnt(0)" ::: "memory");
            }
        }
        }
    }
    GSYNC();

    {
        PH_BEGIN
        SchedStatic S{XN, WT_IN, D, D, 65, 17, G, cu}; EpiProj E{PROJ, RSTD1, U2};
        for (int rep = 0; rep < REP_P1; ++rep) pg8::gemm_phase(lds, D, D, D, S, E);
    }
    GSYNC();

    {
        PH_BEGIN
        const float* mu = IN(I_MU);
        const int skipc = (G >= 256) ? 64 : 0, gt2 = (cu - skipc) * NT + tid, NGT2 = (G - skipc) * NT;
        for (int i = gt2; i >= 0 && i < M * 32; i += NGT2) { const int m = i >> 5, q = i & 31, j0 = 1536 + 8 * q; u32x4 w = (u32x4){0u, 0u, 0u, 0u};
            if (m < MV) { f32x4 p0, p1, r0, r1; unpack8(*(const u32x4*)(PROJ + (size_t)m * INW + j0), p0, p1);
                if (m >= MP) { const float* s = IN(I_SSHIFT) + (size_t)(m - MP) * SHW + j0; r0 = *(const f32x4*)s; r1 = *(const f32x4*)(s + 4); }
                else if ((m & 2047) == 0) { r0 = (f32x4){0.f, 0.f, 0.f, 0.f}; r1 = r0; }
                else unpack8(*(const u32x4*)(PROJ + (size_t)(m - 1) * INW + j0), r0, r1);
                const f32x4 m0 = *(const f32x4*)(mu + j0), m1 = *(const f32x4*)(mu + j0 + 4);
                f32x4 x0 = p0 + (r0 - p0) * m0, x1 = p1 + (r1 - p1) * m1;
                if (q < 8) { x0 = (f32x4){ftanh(x0[0]), ftanh(x0[1]), ftanh(x0[2]), ftanh(x0[3])}; x1 = (f32x4){ftanh(x1[0]), ftanh(x1[1]), ftanh(x1[2]), ftanh(x1[3])}; }
                else if (q >= 16) { x0 = sigm4(x0); x1 = sigm4(x1); }
                w = pack8(x0, x1); }
            *(u32x4*)(LIN + (size_t)m * 256 + 8 * q) = w; }
        for (int i = gt2; i >= 0 && i < (8 + 128) * SHW; i += NGT2) { const int r = i / SHW, j = i % SHW;
            if (r < 8) out[O_PSHIFT + (size_t)r * SHW + j] = bf1(PROJ[(size_t)(r * T + T - 1) * INW + j]); else out[O_SSHIFT + (size_t)(r - 8) * SHW + j] = bf1(PROJ[(size_t)(MP + r - 8) * INW + j]); }
        if (cu >= skipc) {
            LAS float* scr = (LAS float*)(lds + wave * 16384);
            constexpr int I_O2 = (D / 64) * (D / 32), I_FO2 = (DFF / 64) * (D / 32);
            for (int it = (cu - skipc) * NWAVES + wave; it < I_O2 + I_FO2; it += (G - skipc) * NWAVES) {
                if (it < I_O2) transpose_item(IN(I_WOUT), nullptr, D, D, WT_OUT, D, 0, 0, 0, scr, it, lane);
                else transpose_item(IN(I_WFFO), nullptr, DFF, D, WT_FFO, DFF, 0, 0, 0, scr, it - I_O2, lane); }
        }
        SchedS5 S{U2, WSB, (size_t)128 * S5K, S5K, 1, G, cu}; EpiS5E E{EE};
        pg8::gemm_phase(lds, S5K, S5P, S5K, S, E);
    }
    GSYNC();

    {
        PH_BEGIN
        const int gtr = (G - 1 - cu) * NT + tid;
        if (gtr < 32 * 8 * 64) { const int n = gtr & 63, b = (gtr >> 6) & 7, g = gtr >> 9;
            const float dt = expf(IN(I_LOGDT)[g]); const float lr = IN(I_ARE)[g * 64 + n], li = IN(I_AIM)[g * 64 + n]; float sn, cs; const float mg = expf(lr * dt * Q); sincosf(li * dt * Q, &sn, &cs);
            const float qr = mg * cs, qi = mg * sn; float xr = 0.f, xi = 0.f;
            const float* e = EE + ((size_t)g * S5R + b * NCH) * 128 + n; bf16_t* xo = U2 + ((size_t)g * S5R + b * NCH) * S5P + S5K + n;
            float er[NCH], ei[NCH];
#pragma unroll
            for (int k = 0; k < NCH; ++k) { er[k] = e[(size_t)k * 128]; ei[k] = e[(size_t)k * 128 + 64]; }
#pragma unroll
            for (int k = 0; k < NCH; ++k) { const unsigned w = cvt_pk_bf16(xr, xi); xo[(size_t)k * S5P] = (bf16_t)(w & 0xffff); xo[(size_t)k * S5P + 64] = (bf16_t)(w >> 16);
                const float nr = qr * xr - qi * xi + er[k], ni = qr * xi + qi * xr + ei[k]; xr = nr; xi = ni; }
            out[O_PSRE + (size_t)(b * 32 + g) * 64 + n] = xr; out[O_PSIM + (size_t)(b * 32 + g) * 64 + n] = xi; }
        SchedStatic S{LIN, WT_LORA, 256, 256, 65, 6, G, cu}; EpiLora E{LO, IN(I_W0), IN(I_A0)};
        pg8::gemm_phase(lds, 256, 256, 256, S, E);
    }
    GSYNC();

    {
        PH_BEGIN
        const float* mu = IN(I_MU);
        constexpr int TB = 32, STEPF = 6 * 64, BUFF = TB * STEPF;
        LAS float* ring = (LAS float*)lds;
        for (int rep = 0; rep < REP_WKV; ++rep)
        for (int it0 = cu; it0 < 256; it0 += G) {
            const int it = (G == 256) ? ((it0 & 7) * 32 + (it0 >> 3)) : it0;
            const int b = it >> 5, h = (it >> 2) & 7, q = it & 3;
            __syncthreads();
            if (wave >= 4) {
                const int ptid = tid - 256, c0 = (ptid & 15) * 4, j = h * 64 + c0, s0 = ptid >> 4;
                const f32x4 mur = *(const f32x4*)(mu + j), muk = *(const f32x4*)(mu + 512 + j), muv = *(const f32x4*)(mu + 1024 + j);
                const f32x4 kkv = *(const f32x4*)(IN(I_KK) + j), kav = *(const f32x4*)(IN(I_KA) + j), rkv = *(const f32x4*)(IN(I_RK) + j);
                u32x2 ld[2][8];
#define WKV_LOAD(blk) do { _Pragma("unroll") for (int e = 0; e < 2; ++e) { const int t = (blk) * TB + s0 + 16 * e; const size_t m = (size_t)b * T + t; const bf16_t* pr = PROJ + m * INW + j; const bf16_t* pp = pr - INW; \
                    ld[e][0] = *(const u32x2*)pr; ld[e][1] = *(const u32x2*)(pr + 512); ld[e][2] = *(const u32x2*)(pr + 1024); \
                    if (t > 0) { ld[e][3] = *(const u32x2*)pp; ld[e][4] = *(const u32x2*)(pp + 512); ld[e][5] = *(const u32x2*)(pp + 1024); } else { ld[e][3] = (u32x2){0u, 0u}; ld[e][4] = ld[e][3]; ld[e][5] = ld[e][3]; } \
                    ld[e][6] = *(const u32x2*)(LO + m * 1536 + j); ld[e][7] = *(const u32x2*)(LO + m * 1536 + 512 + j); } } while (0)
#define WKV_PROD(blk) do { _Pragma("unroll") for (int e = 0; e < 2; ++e) { const int s = s0 + 16 * e; const size_t m = (size_t)b * T + (blk) * TB + s; \
                    const f32x4 pr = unpack4(ld[e][0]), pk = unpack4(ld[e][1]), pv = unpack4(ld[e][2]), qr = unpack4(ld[e][3]), qk = unpack4(ld[e][4]), qv = unpack4(ld[e][5]), lw = unpack4(ld[e][6]), la = unpack4(ld[e][7]); \
                    const f32x4 r = pr + (qr - pr) * mur, k = pk + (qk - pk) * muk, v = pv + (qv - pv) * muv; f32x4 dec, av, kk, k2; float ss = 0.f, bn = 0.f; \
                    _Pragma("unroll") for (int x = 0; x < 4; ++x) { dec[x] = fexp(-lw[x]); av[x] = la[x]; \
                        kk[x] = k[x] * kkv[x]; ss += kk[x] * kk[x]; k2[x] = k[x] * (1.0f + (av[x] - 1.0f) * kav[x]); bn += r[x] * k2[x] * rkv[x]; } \
                    ss = red16(ss); bn = red16(bn); const float inv = 1.0f / fmaxf(sqrtf(ss), 1e-12f); kk = kk * inv; \
                    if (q == 0 && (ptid & 15) == 0) BONUS[m * 8 + h] = bn; \
                    LAS float* o = wb + s * STEPF + c0; *(LAS f32x4*)o = dec; *(LAS f32x4*)(o + 64) = -kk; *(LAS f32x4*)(o + 128) = kk * av; *(LAS f32x4*)(o + 192) = k2; *(LAS f32x4*)(o + 256) = r; *(LAS f32x4*)(o + 320) = v; } } while (0)
                { WKV_LOAD(0); LAS float* wb = ring; WKV_PROD(0); WKV_LOAD(1); }
                asm volatile("s_waitcnt lgkmcnt(0)" ::: "memory"); __builtin_amdgcn_s_barrier();
                for (int i = 0; i < T / TB; ++i) {
                    if (i + 1 < T / TB) { LAS float* wb = ring + ((i + 1) & 1) * BUFF; WKV_PROD(i + 1); if (i + 2 < T / TB) WKV_LOAD(i + 2); }
                    asm volatile("s_waitcnt lgkmcnt(0)" ::: "memory"); __builtin_amdgcn_s_barrier();
                }
#undef WKV_LOAD
#undef WKV_PROD
            } else {
                const int kq = lane & 15, row = q * 16 + wave * 4 + (lane >> 4);
                f32x2 Sa = (f32x2){0.f, 0.f}, Sb = Sa;
                typedef __attribute__((address_space(1))) bf16_t gbf;
                gbf* yo = (gbf*)(YWKV + ((size_t)b * T + kq) * 512 + h * 64 + row);
                asm volatile("s_waitcnt lgkmcnt(0)" ::: "memory"); __builtin_amdgcn_s_barrier();
#define WKV_LD(P, s_) do { \
                    asm volatile("ds_read_b128 %0, %1 offset:%2" : "=v"(P##w) : "v"(rba), "n"((s_) * 1536)); \
                    asm volatile("ds_read_b128 %0, %1 offset:%2" : "=v"(P##n) : "v"(rba), "n"((s_) * 1536 + 256)); \
                    asm volatile("ds_read_b128 %0, %1 offset:%2" : "=v"(P##b) : "v"(rba), "n"((s_) * 1536 + 512)); \
                    asm volatile("ds_read_b128 %0, %1 offset:%2" : "=v"(P##k) : "v"(rba), "n"((s_) * 1536 + 768)); \
                    asm volatile("ds_read_b128 %0, %1 offset:%2" : "=v"(P##r) : "v"(rba), "n"((s_) * 1536 + 1024)); \
                    asm volatile("ds_read_b32 %0, %1 offset:%2" : "=v"(P##v) : "v"(rva), "n"((s_) * 1536)); } while (0)
#define WKV_WAIT(P, n_) asm volatile("s_waitcnt lgkmcnt(" #n_ ")" : "+v"(P##w), "+v"(P##n), "+v"(P##b), "+v"(P##k), "+v"(P##r), "+v"(P##v))
#define WKV_UPD(src) do { \
                    f32x2 d2 = Sa * (f32x2){src##n[0], src##n[1]}; d2 = Sb * (f32x2){src##n[2], src##n[3]} + d2; float sa = d2[0] + d2[1]; sa = red16(sa); \
                    const f32x2 sa2 = (f32x2){sa, sa}, vv2 = (f32x2){src##v, src##v}; \
                    f32x2 ta = sa2 * (f32x2){src##b[0], src##b[1]}; ta = vv2 * (f32x2){src##k[0], src##k[1]} + ta; Sa = Sa * (f32x2){src##w[0], src##w[1]} + ta; \
                    f32x2 tb = sa2 * (f32x2){src##b[2], src##b[3]}; tb = vv2 * (f32x2){src##k[2], src##k[3]} + tb; Sb = Sb * (f32x2){src##w[2], src##w[3]} + tb; } while (0)
#define WKV_Y(rv, sidx) do { f32x2 y2 = Sa * (f32x2){rv[0], rv[1]}; y2 = Sb * (f32x2){rv[2], rv[3]} + y2; float y = y2[0] + y2[1]; y = red16(y); \
                    ykeep = (kq == ((sidx) & 15)) ? y : ykeep; if ((((sidx) + 1) & 15) == 0) yo[(size_t)(i * TB + (sidx) - 15) * 512] = (bf16_t)(cvt_pk_bf16(ykeep, 0.f) & 0xffffu); } while (0)
#define WKV_PAIR(s_) do { WKV_LD(B, (s_) + 1); WKV_WAIT(A, 6); if ((s_) > 0) WKV_Y(rq, (s_) - 1); rp = Ar; WKV_UPD(A); \
                    if ((s_) + 2 < TB) { WKV_LD(A, ((s_) + 2) & 31); WKV_WAIT(B, 6); } else { WKV_WAIT(B, 0); } WKV_Y(rp, (s_)); rq = Br; WKV_UPD(B); } while (0)
                for (int i = 0; i < T / TB; ++i) {
                    const unsigned rba = (unsigned)((i & 1) * BUFF * 4 + kq * 16), rva = (unsigned)((i & 1) * BUFF * 4 + (320 + row) * 4);
                    f32x4 Aw, An, Ab, Ak, Ar, Bw, Bn, Bb, Bk, Br, rp, rq; float Av, Bv, ykeep = 0.f;
                    WKV_LD(A, 0);
                    WKV_PAIR(0); WKV_PAIR(2); WKV_PAIR(4); WKV_PAIR(6); WKV_PAIR(8); WKV_PAIR(10); WKV_PAIR(12); WKV_PAIR(14);
                    WKV_PAIR(16); WKV_PAIR(18); WKV_PAIR(20); WKV_PAIR(22); WKV_PAIR(24); WKV_PAIR(26); WKV_PAIR(28); WKV_PAIR(30);
                    WKV_Y(rq, 31);
                    asm volatile("s_waitcnt lgkmcnt(0)" ::: "memory"); __builtin_amdgcn_s_barrier();
                }
#undef WKV_UPD
#undef WKV_Y
#undef WKV_PAIR
#undef WKV_WAIT
#undef WKV_LD
                *(f32x4*)(out + O_PWKV + (((size_t)(b * 8 + h) * 64 + row) * 64) + kq * 4) = (f32x4){Sa[0], Sa[1], Sb[0], Sb[1]};
            }
        }
        __syncthreads();
        {
            LAS float* ops = (LAS float*)lds;
            const int hb = (G >= 256) ? G / 2 : 0;
            for (int it = cu - hb; it >= 0 && it < 128; it += G - hb) {
                const int bh = it * 8 + wave, b = bh >> 3, h = bh & 7, c = lane, j = h * 64 + c; const size_t m = MP + b;
                __syncthreads();
                { const bf16_t* pr = PROJ + m * INW + j; const float* st = IN(I_SSHIFT) + (size_t)b * SHW + j;
                  const float p_r = bf1(pr[0]), p_k = bf1(pr[512]), p_v = bf1(pr[1024]);
                  const float r = p_r + (st[0] - p_r) * mu[j], k = p_k + (st[512] - p_k) * mu[512 + j], v = p_v + (st[1024] - p_v) * mu[1024 + j];
                  const float dec = fexp(-bf1(LO[m * 1536 + j]));
                  const float av = bf1(LO[m * 1536 + 512 + j]); float kk = k * IN(I_KK)[j]; const float ss = wave_sum(kk * kk); kk = kk / fmaxf(sqrtf(ss), 1e-12f);
                  const float k2 = k * (1.0f + (av - 1.0f) * IN(I_KA)[j]); const float bn = wave_sum(r * k2 * IN(I_RK)[j]); if (lane == 0) BONUS[m * 8 + h] = bn;
                  LAS float* o = ops + wave * STEPF + c; o[0] = dec; o[64] = -kk; o[128] = kk * av; o[192] = k2; o[256] = r; o[320] = v; }
                __syncthreads();
                { const LAS float* o = ops + wave * STEPF; const int v = lane; const float* sp = IN(I_SWKV) + ((size_t)bh * 64 + v) * 64; float* so = out + O_SWKV + ((size_t)bh * 64 + v) * 64;
                  f32x4 Sv[16]; float sa = 0.f;
#pragma unroll
                  for (int x = 0; x < 16; ++x) { Sv[x] = *(const f32x4*)(sp + 4 * x); const f32x4 nk = *(const LAS f32x4*)(o + 64 + 4 * x); sa += (Sv[x][0] * nk[0] + Sv[x][1] * nk[1]) + (Sv[x][2] * nk[2] + Sv[x][3] * nk[3]); }
                  const float vv = o[320 + v]; float y = 0.f;
#pragma unroll
                  for (int x = 0; x < 16; ++x) { const f32x4 w = *(const LAS f32x4*)(o + 4 * x), bb = *(const LAS f32x4*)(o + 128 + 4 * x), k = *(const LAS f32x4*)(o + 192 + 4 * x), r = *(const LAS f32x4*)(o + 256 + 4 * x);
                      const f32x4 sn = Sv[x] * w + (bb * sa + k * vv); *(f32x4*)(so + 4 * x) = sn; y += (sn[0] * r[0] + sn[1] * r[1]) + (sn[2] * r[2] + sn[3] * r[3]); }
                  YWKV[m * 512 + h * 64 + v] = (bf16_t)(cvt_pk_bf16(y, 0.f) & 0xffffu); }
            }
            __syncthreads();
        }
        for (int it = (cu - ((G >= 256) ? G / 2 : 0)) * NWAVES + wave; it >= 0 && it < 128 * 32; it += (G - ((G >= 256) ? G / 2 : 0)) * NWAVES) { const int b = it >> 5, g = it & 31, n = lane; const size_t m = MP + b;
            const float dt = __expf(IN(I_LOGDT)[g]); const float lr = IN(I_ARE)[g * 64 + n], li = IN(I_AIM)[g * 64 + n]; float sn, cs; const float mg = __expf(lr * dt); sincosf(li * dt, &sn, &cs);
            const float ar = mg * cs, ai = mg * sn, den = lr * lr + li * li, fr_ = ((ar - 1.0f) * lr + ai * li) / den, fi_ = (ai * lr - (ar - 1.0f) * li) / den;
            const float x0r = IN(I_SSRE)[((size_t)b * 32 + g) * 64 + n], x0i = IN(I_SSIM)[((size_t)b * 32 + g) * 64 + n];
            float xr = ar * x0r - ai * x0i, xi = ar * x0i + ai * x0r;
            const bf16_t* up = PROJ + m * INW + COL_U + g * 16;
#pragma unroll
            for (int c = 0; c < 16; ++c) { const float uu = bf1(up[c]); const float br = IN(I_BRE)[(g * 64 + n) * 16 + c], bi = IN(I_BIM)[(g * 64 + n) * 16 + c]; xr += uu * (fr_ * br - fi_ * bi); xi += uu * (fr_ * bi + fi_ * br); }
            out[O_SSRE + ((size_t)b * 32 + g) * 64 + n] = xr; out[O_SSIM + ((size_t)b * 32 + g) * 64 + n] = xi;
            float myz = 0.f;
#pragma unroll
            for (int c = 0; c < 16; ++c) { float yv = IN(I_CRE)[(g * 16 + c) * 64 + n] * xr - IN(I_CIM)[(g * 16 + c) * 64 + n] * xi; yv = wave_sum(yv); if (lane == c) myz = yv; }
            if (lane < 16) { const float uu = bf1(up[lane]); const float ys = myz + IN(I_DSK)[g * 16 + lane] * uu; const unsigned w = cvt_pk_bf16(gelu_t(ys), 0.f); ZB[m * 512 + g * 16 + lane] = (bf16_t)(w & 0xffff); }
        }
        SchedS5 S{U2, BTY, (size_t)512 * S5P, S5P, 2, G, cu}; EpiS5Y E{ZB, U2, IN(I_DSK)};
        pg8::gemm_phase(lds, S5P, S5P, S5P, S, E);
    }
    GSYNC();

    {
        PH_BEGIN
        const float* mu = IN(I_MU);
        {
            const int j0 = lane * 8, h = lane >> 3;
            const f32x4 mu0 = *(const f32x4*)(mu + 1024 + j0), mu1 = *(const f32x4*)(mu + 1024 + j0 + 4);
            const f32x4 lg0 = *(const f32x4*)(IN(I_LNXG) + j0), lg1 = *(const f32x4*)(IN(I_LNXG) + j0 + 4), lb0 = *(const f32x4*)(IN(I_LNXB) + j0), lb1 = *(const f32x4*)(IN(I_LNXB) + j0 + 4);
            for (int rep = 0; rep < REP_P5; ++rep)
#pragma unroll 2
            for (int m = gw; m < MV; m += NGW) {
                f32x4 y0, y1; unpack8(LDNT(u32x4, YWKV + (size_t)m * 512 + j0), y0, y1);
                f32x4 p0, p1, q0, q1, g0, g1; unpack8(LDNT(u32x4, PROJ + (size_t)m * INW + 1024 + j0), p0, p1); unpack8(LDNT(u32x4, LO + (size_t)m * 1536 + 1024 + j0), g0, g1);
                if (m >= MP) { const float* st = IN(I_SSHIFT) + (size_t)(m - MP) * SHW + 1024 + j0; q0 = *(const f32x4*)st; q1 = *(const f32x4*)(st + 4); }
                else if ((m & 2047) == 0) { q0 = (f32x4){0.f, 0.f, 0.f, 0.f}; q1 = q0; }
                else unpack8(*(const u32x4*)(PROJ + (size_t)(m - 1) * INW + 1024 + j0), q0, q1);
                const float bn = BONUS[(size_t)m * 8 + h];
                float sm = ((y0[0] + y0[1]) + (y0[2] + y0[3])) + ((y1[0] + y1[1]) + (y1[2] + y1[3]));
                sm += dppf<0xB1>(sm); sm += dppf<0x4E>(sm); sm += dppf<0x141>(sm);
                const float mean = sm * (1.0f / 64.0f); const f32x4 d0 = y0 - mean, d1 = y1 - mean;
                float vs = sq4(d0) + sq4(d1); vs += dppf<0xB1>(vs); vs += dppf<0x4E>(vs); vs += dppf<0x141>(vs);
                const float rs = __builtin_amdgcn_rsqf(vs * (1.0f / 64.0f) + GN_EPS);
                const f32x4 v0 = p0 + (q0 - p0) * mu0, v1 = p1 + (q1 - p1) * mu1;
                const f32x4 o0 = (d0 * rs * lg0 + lb0 + v0 * bn) * g0, o1 = (d1 * rs * lg1 + lb1 + v1 * bn) * g1;
                *(u32x4*)(YG + (size_t)m * 512 + j0) = pack8(o0, o1);
            }
        }
        for (int i = gt; i < (M - MV) * 512; i += NGT) YG[(size_t)MV * 512 + i] = 0;
        __syncthreads();
        LAS float* scr = (LAS float*)(lds + wave * 16384);
        constexpr int I_O = (D / 64) * (D / 32), I_FI = (D / 64) * (2 * DFF / 32), I_FO = (DFF / 64) * (D / 32), I_PL = (PLE / 64) * (D / 32);
        constexpr int NITEMS = I_O + I_FI + I_PL; (void)I_FO;
        for (int it = gw; it < NITEMS; it += NGW) {
            int r = it;
            if (r < I_O) { transpose_item(IN(I_WPG), IN(I_LN3), D, D, WT_PG, D, 0, 0, 0, scr, r, lane); continue; } r -= I_O;
            if (r < I_FI) { transpose_item(IN(I_WFFI), IN(I_LN2), D, 2 * DFF, WT_FFI, D, 0, 0, DFF, scr, r, lane); continue; } r -= I_FI;
            transpose_item(IN(I_WPLE), nullptr, PLE, D, WT_PLE, PLE, 0, 0, 0, scr, r, lane);
        }
    }
    GSYNC();

    {
        PH_BEGIN
        { LAS f32x4* red = (LAS f32x4*)lds; const int fr = lane & 15, fq = lane >> 4;
          for (int t = cu; t < 8 * 64; t += G) { const int rb = t & 7, cb = t >> 3, j0 = cb * 16, row = MP + rb * 16 + fr, col = j0 + 4 * fq;
            const bf16_t* wa = WT_GLU + (size_t)((j0 >> 7) * 256 + (j0 & 127)) * 512;
            skinny_put(red, 0, wave, lane, skinny_part(ZB + (size_t)(MP + rb * 16) * 512, 512, wa, 512, wave * 64, 64, fr, fq));
            skinny_put(red, 1, wave, lane, skinny_part(ZB + (size_t)(MP + rb * 16) * 512, 512, wa + 128 * 512, 512, wave * 64, 64, fr, fq));
            skinny_put(red, 2, wave, lane, skinny_part(YG + (size_t)(MP + rb * 16) * 512, 512, WT_RW + (size_t)j0 * 512, 512, wave * 64, 64, fr, fq));
            __syncthreads();
            if (wave == 0) { const f32x4 za = skinny_get(red, 0, lane), zb = skinny_get(red, 1, lane), rr = skinny_get(red, 2, lane);
                const f32x4 g1 = unpack4(*(const u32x2*)(PROJ + (size_t)row * INW + COL_G1 + col)), g2 = unpack4(*(const u32x2*)(PROJ + (size_t)row * INW + COL_G2 + col));
                *(u32x2*)(MG + (size_t)row * D + col) = pack4(sigm4(g1) * rr + sigm4(g2) * za * sigm4(zb)); }
            __syncthreads(); } }
        SchedGluRw S{ZB, YG, WT_GLU, WT_RW, 64, G, cu}; EpiGluRw E{T1, MG, PROJ};
        pg8::gemm_phase(lds, 512, 512, 512, S, E);
    }
    GSYNC();

    {
        PH_BEGIN
        { LAS f32x4* red = (LAS f32x4*)lds; const int fr = lane & 15, fq = lane >> 4;
          for (int t = cu; t < 8 * 64; t += G) { const int rb = t & 7, cb = t >> 3, row = MP + rb * 16 + fr, col = cb * 16 + 4 * fq;
            skinny_put(red, 0, wave, lane, skinny_part(MG + (size_t)(MP + rb * 16) * D, D, WT_OUT + (size_t)cb * 16 * D, D, wave * 128, 128, fr, fq));
            __syncthreads();
            if (wave == 0) { const f32x4 v = *(const f32x4*)(IN(I_XS) + (size_t)(rb * 16 + fr) * D + col) + skinny_get(red, 0, lane);
                *(u32x2*)(XB + (size_t)row * D + col) = pack4(v);
                float sq = sq4(v); sq += __shfl_xor(sq, 16); sq += __shfl_xor(sq, 32); if (fq == 0) atomicAdd(SSQ2 + row, sq); }
            __syncthreads(); } }
        SchedStatic S{MG, WT_OUT, D, D, 64, 4, G, cu}; EpiRes1 E{IN(I_XP), IN(I_XS), XB, SSQ2};
        pg8::gemm_phase(lds, D, D, D, S, E);
    }
    GSYNC();

    {
        PH_BEGIN
        SchedStatic S{XB, WT_FFI, D, D, 65, 22, G, cu}; EpiFfn E{HG, SSQ2, IN(I_CW), IN(I_CB), SA, SB, IN(I_SCONV), out, (LAS float*)(lds + XLDS_OFF)};
        for (int rep = 0; rep < REP_P9; ++rep) pg8::gemm_phase(lds, D, D, D, S, E);
        { const int extra = (65 * 22) % G; SchedTail S2{PBF, WT_PLE, PLE, PLE, extra, G - extra, 64 * 4, 4, cu}; EpiBf E2{PEB, D}; pg8::gemm_phase(lds, PLE, PLE, PLE, S2, E2); }
    }
    GSYNC();

    {
        PH_BEGIN
        { LAS f32x4* red = (LAS f32x4*)lds; const int fr = lane & 15, fq = lane >> 4;
          for (int t = cu; t < 8 * 64; t += G) { const int rb = t & 7, cb = t >> 3, row = MP + rb * 16 + fr, col = cb * 16 + 4 * fq;
            skinny_put(red, 0, wave, lane, skinny_part(HG + (size_t)(MP + rb * 16) * DFF, DFF, WT_FFO + (size_t)cb * 16 * DFF, DFF, wave * 352, 352, fr, fq));
            __syncthreads();
            if (wave == 0) { const f32x4 v = unpack4(*(const u32x2*)(XB + (size_t)row * D + col)) + skinny_get(red, 0, lane);
                *(u32x2*)(XB + (size_t)row * D + col) = pack4(v);
                float sq = sq4(v); sq += __shfl_xor(sq, 16); sq += __shfl_xor(sq, 32); if (fq == 0) atomicAdd(SSQ3 + row, sq); }
            __syncthreads(); } }
        SchedStatic S{HG, WT_FFO, DFF, DFF, 64, 4, G, cu}; EpiRes2 E{XB, SSQ3};
        const float* cw = IN(I_CW); const float* cb = IN(I_CB);
        for (int i = 0;; ++i) { Unit u; if (!S.next(i, u)) break; const int pm = u.pm; if (pm >= 64 || (pm & 7) == 0) continue;
            for (int e = tid; e < 2 * (DFF / 4); e += NT) { const int r = e / (DFF / 4), col = (e % (DFF / 4)) * 4;
                const f32x4 am2 = *(const f32x4*)(SA + ((size_t)(pm - 1) * 4 + 2) * DFF + col), am1 = *(const f32x4*)(SA + ((size_t)(pm - 1) * 4 + 3) * DFF + col);
                const f32x4 a0 = *(const f32x4*)(SA + ((size_t)pm * 4 + 0) * DFF + col), a1 = *(const f32x4*)(SA + ((size_t)pm * 4 + 1) * DFF + col);
                const f32x4 w0 = *(const f32x4*)(cw + col), w1 = *(const f32x4*)(cw + DFF + col), w2 = *(const f32x4*)(cw + 2 * DFF + col), bb = *(const f32x4*)(cb + col);
                const f32x4 sb = *(const f32x4*)(SB + ((size_t)pm * 2 + r) * DFF + col);
                const f32x4 cv = r == 0 ? (w0 * am2 + w1 * am1 + w2 * a0 + bb) : (w0 * am1 + w1 * a0 + w2 * a1 + bb);
                *(u32x2*)(HG + ((size_t)pm * 256 + r) * DFF + col) = pack4(gelu4(cv) * sb); } }
        asm volatile("s_waitcnt vmcnt(0)" ::: "memory"); __threadfence(); __syncthreads();
        pg8::gemm_phase(lds, DFF, DFF, DFF, S, E);
    }
    GSYNC();

    {
        PH_BEGIN
        unsigned* ctl = (unsigned*)(ws + SM_BAR);
        { LAS f32x4* red = (LAS f32x4*)lds; const int fr = lane & 15, fq = lane >> 4;
          for (int t = cu; t < 8 * 64; t += G) { const int rb = t & 7, cb = t >> 3, row = MP + rb * 16 + fr, col = cb * 16 + 4 * fq;
            skinny_put(red, 0, wave, lane, skinny_part(PBF + (size_t)(MP + rb * 16) * PLE, PLE, WT_PLE + (size_t)cb * 16 * PLE, PLE, wave * 32, 32, fr, fq));
            skinny_put(red, 1, wave, lane, skinny_part(XB + (size_t)(MP + rb * 16) * D, D, WT_PG + (size_t)cb * 16 * D, D, wave * 128, 128, fr, fq));
            __syncthreads();
            if (wave == 0) { const f32x4 pe = skinny_get(red, 0, lane), gg = skinny_get(red, 1, lane);
                const float rs = __builtin_amdgcn_rsqf(SSQ3[row] * (1.0f / D) + EPS);
                const f32x4 v = unpack4(*(const u32x2*)(XB + (size_t)row * D + col)) + sigm4(gg * rs) * pe;
                float* xo = X + (size_t)row * D + col;
#pragma unroll
                for (int e = 0; e < 4; ++e) __hip_atomic_store(xo + e, v[e], __ATOMIC_RELAXED, __HIP_MEMORY_SCOPE_AGENT);
                float sq = sq4(v); sq += __shfl_xor(sq, 16); sq += __shfl_xor(sq, 32); if (fq == 0) atomicAdd(SSQF + row, sq);
                asm volatile("s_waitcnt vmcnt(0)" ::: "memory");
                if (lane == 0) __hip_atomic_fetch_add(ctl + CW_SKINNY, 1u, __ATOMIC_RELAXED, __HIP_MEMORY_SCOPE_AGENT); }
            __syncthreads(); } }
        { SchedStatic S{XB, WT_PG, D, D, 64, 4, G, cu}; EpiPleFinal E{X, XB, PEB, SSQ3, SSQF, ctl + CW_PANEL, IN(I_FG)}; pg8::gemm_phase(lds, D, D, D, S, E); }
        if (wave == 0 && cu < MS) {
            unsigned sp = 0; while (__hip_atomic_load(ctl + CW_SKINNY, __ATOMIC_RELAXED, __HIP_MEMORY_SCOPE_AGENT) < 512u) { __builtin_amdgcn_s_sleep(2); if (++sp > (1u << 20)) break; }
            __builtin_amdgcn_fence(__ATOMIC_ACQUIRE, "agent"); asm volatile("s_waitcnt vmcnt(0)" ::: "memory");
            const int m = MP + cu; const float rs = __builtin_amdgcn_rsqf(__hip_atomic_load(SSQF + m, __ATOMIC_RELAXED, __HIP_MEMORY_SCOPE_AGENT) * (1.0f / D) + EPS);
            f32x4* xr = (f32x4*)(X + (size_t)m * D) + lane;
#pragma unroll
            for (int j = 0; j < 4; ++j) xr[64 * j] = xr[64 * j] * rs * *((const f32x4*)IN(I_FG) + lane + 64 * j);
        }
    }
    for (int i = 0; i < EXTRA_SYNC; ++i) GSYNC();
}

extern "C" void kernel_launch(void* const* d_in, const int* in_sizes, int n_in, void* d_out, int out_size, void* d_ws, size_t ws_size, hipStream_t stream) {
    static int grid = 0;
    if (grid == 0) {
        if (n_in != 42 || (size_t)out_size != O_END || ws_size < WS_END) { fprintf(stderr, "kernel_launch: unexpected sizes n_in %d out %d ws %zu (need %zu)\n", n_in, out_size, ws_size, (size_t)WS_END); grid = -1; return; }
        int dev = 0, cus = 0, per_cu = 0;
        if (hipGetDevice(&dev) != hipSuccess || hipDeviceGetAttribute(&cus, hipDeviceAttributeMultiprocessorCount, dev) != hipSuccess) { grid = -1; return; }
        if (hipFuncSetAttribute((const void*)fwd, hipFuncAttributeMaxDynamicSharedMemorySize, LDS_BYTES) != hipSuccess) { fprintf(stderr, "kernel_launch: hipFuncSetAttribute failed\n"); grid = -1; return; }
        if (hipOccupancyMaxActiveBlocksPerMultiprocessor(&per_cu, (const void*)fwd, NT, LDS_BYTES) != hipSuccess || per_cu < 1) { fprintf(stderr, "kernel_launch: occupancy query says %d\n", per_cu); (void)hipGetLastError(); grid = -1; return; }
        grid = cus;
    }
    if (grid < 0) return;
    if (hipMemsetAsync((char*)d_ws + SM_BAR, 0, (size_t)CTL_WORDS * 4, stream) != hipSuccess) { fprintf(stderr, "kernel_launch: memset failed\n"); return; }
    Args a{};
    for (int i = 0; i < 42; ++i) a.in[i] = (const float*)d_in[i];
    a.out = (float*)d_out; a.ws = (unsigned char*)d_ws;
    void* kargs[] = {&a};
    hipError_t e = hipLaunchCooperativeKernel((const void*)fwd, dim3(grid), dim3(NT), kargs, LDS_BYTES, stream);
    if (e != hipSuccess) fprintf(stderr, "kernel_launch: cooperative launch failed: %s\n", hipGetErrorString(e));
}
```

```cpp
#include <hip/hip_runtime.h>
#include <hip/hip_cooperative_groups.h>
#include <cstdio>
#include <cstdint>
namespace cg = cooperative_groups;

#define LAS __attribute__((address_space(3)))
typedef unsigned short bf16_t;
typedef short bf16x8 __attribute__((ext_vector_type(8)));
typedef float f32x4 __attribute__((ext_vector_type(4)));
typedef float f32x2 __attribute__((ext_vector_type(2)));
typedef unsigned u32x4 __attribute__((ext_vector_type(4)));
typedef unsigned u32x2 __attribute__((ext_vector_type(2)));

constexpr int D = 1024, MP = 16384, MS = 128, MV = MP + MS, M = 16640, T = 2048;
constexpr int INW = 4352, SHW = 1792, DFF = 2816, PLE = 256;
constexpr int COL_U = 1792, COL_G1 = 2304, COL_G2 = 3328;
constexpr float EPS = 1e-6f, GN_EPS = 64e-5f;
constexpr int NWAVES = 8, NT = 512, XCD_BAR_WORDS_C = 3456;
constexpr int Q = 32, NCH = T / Q  , S5R = 8 * NCH  , S5K = Q * 16  , S5P = S5K + 128  ;

constexpr size_t al4k(size_t x) { return (x + 4095) & ~(size_t)4095; }
constexpr size_t WS_WT_IN = 0;
constexpr size_t WS_WT_LORA = al4k(WS_WT_IN + (size_t)INW * D * 2);
constexpr size_t WS_WT_RW = al4k(WS_WT_LORA + (size_t)1536 * 256 * 2);
constexpr size_t WS_WT_GLU = al4k(WS_WT_RW + (size_t)1024 * 512 * 2);
constexpr size_t WS_SMALL = al4k(WS_WT_GLU + (size_t)2048 * 512 * 2);
constexpr size_t SM_RSTD1 = WS_SMALL, SM_SSQ2 = SM_RSTD1 + M * 4, SM_SSQ3 = SM_SSQ2 + M * 4, SM_SSQF = SM_SSQ3 + M * 4, SM_BONUS = SM_SSQF + M * 4;
constexpr size_t SM_SA = al4k(SM_BONUS + (size_t)M * 8 * 4), SM_SB = al4k(SM_SA + (size_t)65 * 4 * DFF * 4);
constexpr size_t SM_BAR = al4k(SM_SB + (size_t)65 * 2 * DFF * 4);
constexpr int CTL_WORDS = 8192 + 64, CW_PANEL = 4096, CW_SKINNY = 8192;
constexpr size_t WS_PBF = al4k(SM_BAR + (size_t)CTL_WORDS * 4);
constexpr size_t WS_S5 = al4k(WS_PBF + (size_t)M * PLE * 2);
constexpr size_t S5_BTY = WS_S5, S5_WSB = al4k(S5_BTY + (size_t)32 * 512 * S5P * 2), S5_U2 = al4k(S5_WSB + (size_t)(32 * 128 + 128) * S5K * 2);
constexpr size_t S5_EE = al4k(S5_U2 + (size_t)32 * S5R * S5P * 2), S5_END = al4k(S5_EE + (size_t)32 * S5R * 128 * 4);
constexpr size_t WS_WT_OUT = WS_WT_IN, WS_WT_FFO = al4k(WS_WT_OUT + (size_t)D * D * 2);
static_assert(WS_WT_FFO + (size_t)D * DFF * 2 <= WS_WT_LORA, "w_out + w_ffn_out fit in WT_IN's space");
constexpr size_t WS_WT_FFI = WS_S5;
constexpr size_t WS_WT_PG = al4k(WS_WT_FFI + (size_t)2 * DFF * D * 2), WS_WT_PLE = al4k(WS_WT_PG + (size_t)D * D * 2), WS_YG = al4k(WS_WT_PLE + (size_t)D * PLE * 2);
constexpr size_t LATE_END = al4k(WS_YG + (size_t)M * 512 * 2);
static_assert(LATE_END <= S5_END, "late overlay fits");
constexpr size_t WS_RA = S5_END;
constexpr size_t WS_PROJ = al4k(WS_RA + (size_t)M * D * 2);
constexpr size_t WS_XB = WS_PROJ, WS_HG = al4k(WS_XB + (size_t)M * D * 2), WS_PE = WS_HG;
constexpr size_t WS_END = al4k(WS_PROJ + (size_t)M * INW * 2);
static_assert(WS_HG + (size_t)M * DFF * 2 <= WS_END && WS_PE + (size_t)M * D * 4 <= WS_END, "overlay");
static_assert(WS_END <= (size_t)256 * 1024 * 1024, "ws budget");
constexpr size_t DO_LO = 0, DO_Z = (size_t)MV * 1536 * 2, DO_T1 = 0;
static_assert(DO_Z + (size_t)MV * 512 * 2 <= (size_t)MV * D * 4, "d_out scratch");
constexpr size_t O_Y = 0, O_PSHIFT = (size_t)MV * D, O_PWKV = O_PSHIFT + 8 * SHW, O_PSRE = O_PWKV + 8 * 8 * 4096, O_PSIM = O_PSRE + 8 * 32 * 64;
constexpr size_t O_PCONV = O_PSIM + 8 * 32 * 64, O_SSHIFT = O_PCONV + 8 * 2 * DFF, O_SWKV = O_SSHIFT + 128 * SHW, O_SSRE = O_SWKV + (size_t)128 * 8 * 4096;
constexpr size_t O_SSIM = O_SSRE + 128 * 32 * 64, O_SCONV = O_SSIM + 128 * 32 * 64, O_END = O_SCONV + 128 * 2 * DFF;

constexpr int REP_P0 = 1, REP_WKV = 1, REP_P1 = 1, REP_P9 = 1, REP_P5 = 1, EXTRA_SYNC = 0;
constexpr int RING_BYTES = 131072, XLDS_OFF = RING_BYTES, LDS_BYTES = 147456;

__device__ __forceinline__ unsigned cvt_pk_bf16(float lo, float hi) { unsigned r; asm("v_cvt_pk_bf16_f32 %0, %1, %2" : "=v"(r) : "v"(lo), "v"(hi)); return r; }
__device__ __forceinline__ u32x4 pack8(f32x4 a, f32x4 b) { u32x4 w; w.x = cvt_pk_bf16(a[0], a[1]); w.y = cvt_pk_bf16(a[2], a[3]); w.z = cvt_pk_bf16(b[0], b[1]); w.w = cvt_pk_bf16(b[2], b[3]); return w; }
__device__ __forceinline__ float bflo(unsigned w) { return __builtin_bit_cast(float, w << 16); }
__device__ __forceinline__ float bfhi(unsigned w) { return __builtin_bit_cast(float, w & 0xffff0000u); }
__device__ __forceinline__ void unpack8(u32x4 w, f32x4& a, f32x4& b) { a = (f32x4){bflo(w.x), bfhi(w.x), bflo(w.y), bfhi(w.y)}; b = (f32x4){bflo(w.z), bfhi(w.z), bflo(w.w), bfhi(w.w)}; }
__device__ __forceinline__ f32x4 unpack4(u32x2 w) { return (f32x4){bflo(w.x), bfhi(w.x), bflo(w.y), bfhi(w.y)}; }
#define LDNT(T, p) __builtin_nontemporal_load((const T*)(p))
__device__ __forceinline__ float bf1(bf16_t h) { return __builtin_bit_cast(float, (unsigned)h << 16); }
__device__ __forceinline__ float fexp(float x) { return __builtin_amdgcn_exp2f(x * 1.4426950408889634f); }
__device__ __forceinline__ float sigm(float x) { return __builtin_amdgcn_rcpf(1.0f + fexp(-x)); }
__device__ __forceinline__ float ftanh(float x) { return 1.0f - 2.0f * __builtin_amdgcn_rcpf(1.0f + fexp(2.0f * x)); }
__device__ __forceinline__ float gelu_t(float x) { const float z = 0.7978845608028654f * (x + 0.044715f * x * x * x); return x * sigm(2.0f * z); }
__device__ __forceinline__ f32x4 sigm4(f32x4 v) {
    const f32x4 a = v * (-1.4426950408889634f);
    f32x4 e; e[0] = __builtin_amdgcn_exp2f(a[0]); e[1] = __builtin_amdgcn_exp2f(a[1]); e[2] = __builtin_amdgcn_exp2f(a[2]); e[3] = __builtin_amdgcn_exp2f(a[3]);
    const f32x4 d = e + 1.0f;
    return (f32x4){__builtin_amdgcn_rcpf(d[0]), __builtin_amdgcn_rcpf(d[1]), __builtin_amdgcn_rcpf(d[2]), __builtin_amdgcn_rcpf(d[3])};
}
__device__ __forceinline__ f32x2 gelu2(f32x2 x) {
    const f32x2 q = (x * x) * (-0.10294324f) + (-2.3022082f); const f32x2 a = x * q;
    f32x2 e; e.x = __builtin_amdgcn_exp2f(a.x); e.y = __builtin_amdgcn_exp2f(a.y);
    const f32x2 d = e + 1.0f; f32x2 r; r.x = __builtin_amdgcn_rcpf(d.x); r.y = __builtin_amdgcn_rcpf(d.y);
    return x * r;
}
__device__ __forceinline__ f32x4 gelu4(f32x4 v) { const f32x2 a = gelu2((f32x2){v[0], v[1]}), b = gelu2((f32x2){v[2], v[3]}); return (f32x4){a.x, a.y, b.x, b.y}; }
__device__ __forceinline__ float wave_sum(float v) {
#pragma unroll
    for (int o = 1; o < 64; o <<= 1) v += __shfl_xor(v, o);
    return v;
}
template <int CTRL> __device__ __forceinline__ float dppf(float x) { return __builtin_bit_cast(float, __builtin_amdgcn_update_dpp(0, __builtin_bit_cast(int, x), CTRL, 0xf, 0xf, true)); }
__device__ __forceinline__ float red16(float x) {
    x += dppf<0xB1>(x); x += dppf<0x4E>(x); x += dppf<0x141>(x); x += dppf<0x140>(x); return x;
}

namespace pg8 {
constexpr int BM = 256, BK = 64, HALF = 128, HTB = HALF * BK * 2, STAGE_BYTES = 8 * HTB;
__host__ __device__ __forceinline__ int lds_byte(int r, int c) { const int st = (r >> 4) * 2 + (c >> 5), rr = r & 15, cc = c & 31, ob = rr * 64 + cc * 2; return st * 1024 + (ob ^ (((ob >> 9) & 1) << 5)); }
__host__ __device__ __forceinline__ void stage_rc(int b, int& R, int& C) { const int st = b / 1024, sb = b % 1024, swz = sb ^ (((sb >> 9) & 1) << 5); R = (st >> 1) * 16 + swz / 64; C = (st & 1) * 32 + (swz % 64) / 2; }
__host__ __device__ __forceinline__ int perm32(int rho) { const int n = rho >> 4, i = rho & 15; return 8 * (i >> 2) + 4 * n + (i & 3); }
struct Unit { int pm, pn, gi; };
constexpr int NXCD = 8, WGM = 8;
__device__ __forceinline__ bool static_tile(int nM, int nN, int G, int c, int i, int& pm, int& pn) {
    const int nwg = nM * nN; const long L = (long)i * G + c; if (L >= nwg) return false;
    int wgid = (int)L; { const int q = nwg / NXCD, r = nwg % NXCD, xcd = wgid % NXCD, off = wgid / NXCD; wgid = (xcd < r ? xcd * (q + 1) : r * (q + 1) + (xcd - r) * q) + off; }
    const int nig = WGM * nN, gid = wgid / nig, fm = gid * WGM, gsz = (nM - fm) < WGM ? (nM - fm) : WGM;
    pm = fm + ((wgid % nig) % gsz); pn = (wgid % nig) / gsz; return true;
}

template <class Epi, class Sched>
__device__ __forceinline__ void gemm_phase(LAS unsigned char* lds, const int K, const int lda, const int ldb, const Sched& S, const Epi& E) {
    int tid = threadIdx.x; asm volatile("" : "+v"(tid));
    const int wid = __builtin_amdgcn_readfirstlane(tid >> 6), lane = tid & 63, wr = wid >> 2, wc = wid & 3, fr = lane & 15, fq = lane >> 4;
    const int nt = K / BK;
    unsigned voffA[2], voffB[2];
#pragma unroll
    for (int i = 0; i < 2; ++i) { int R, C; stage_rc(tid * 16 + i * 8192, R, C); const int Rb = (R & ~31) + perm32(R & 31);
        voffA[i] = (unsigned)(R * lda + C) * 2u; voffB[i] = (unsigned)(Rb * ldb + C) * 2u; }
    const size_t kstep = (size_t)(BK * 2);
    const size_t hstepA = (size_t)HALF * lda * 2, hstepB = (size_t)HALF * ldb * 2;
    const unsigned ldsw = (unsigned)wid * 1024u;
    const int aoff = lds_byte(wr * 64 + fr, fq * 8), boff = lds_byte(wc * 32 + fr, fq * 8);
#define PG8_SA(b, h) (((b) * 2 + (h)) * HTB)
#define PG8_SB(b, h) ((4 + (b) * 2 + (h)) * HTB)
#define PG8_STAGE(bufoff, gbase, voff) do { _Pragma("unroll") for (int _i = 0; _i < 2; ++_i) \
        __builtin_amdgcn_global_load_lds((const unsigned*)((const char*)(gbase) + (voff)[_i]), (LAS unsigned*)(lds + (bufoff) + ldsw + _i * 8192), 16, 0, 0); } while (0)
#define PG8_LDA(dst, b, h) do { _Pragma("unroll") for (int m = 0; m < 4; ++m) _Pragma("unroll") for (int k = 0; k < 2; ++k) dst[m][k] = *(const LAS bf16x8*)(lds + PG8_SA(b, h) + aoff + m * 2048 + k * 1024); } while (0)
#define PG8_LDB(dst, b, h) do { _Pragma("unroll") for (int n = 0; n < 2; ++n) _Pragma("unroll") for (int k = 0; k < 2; ++k) dst[n][k] = *(const LAS bf16x8*)(lds + PG8_SB(b, h) + boff + n * 2048 + k * 1024); } while (0)
#define PG8_MMA(ai, bj, At, Bt) do { __builtin_amdgcn_s_setprio(1); _Pragma("unroll") for (int m = 0; m < 4; ++m) _Pragma("unroll") for (int n = 0; n < 2; ++n) _Pragma("unroll") for (int k = 0; k < 2; ++k) \
        acc[ai][bj][m][n] = __builtin_amdgcn_mfma_f32_16x16x32_bf16(Bt[n][k], At[m][k], acc[ai][bj][m][n], 0, 0, 0); __builtin_amdgcn_s_setprio(0); } while (0)
#define PG8_WAIT_V(n) asm volatile("s_waitcnt vmcnt(" #n ")" ::: "memory")
#define PG8_WAIT_L(n) asm volatile("s_waitcnt lgkmcnt(" #n ")" ::: "memory")
#define PG8_BAR __builtin_amdgcn_s_barrier()
#define PG8_SCHED __builtin_amdgcn_sched_barrier(0)
    Unit cur, nxt; int ui = 0;
    if (!S.next(0, cur)) return;
    f32x4 acc[2][2][4][2];
#pragma unroll
    for (int a = 0; a < 2; ++a)
#pragma unroll
        for (int b = 0; b < 2; ++b)
#pragma unroll
            for (int m = 0; m < 4; ++m)
#pragma unroll
                for (int n = 0; n < 2; ++n) acc[a][b][m][n] = (f32x4){0.f, 0.f, 0.f, 0.f};
    bf16x8 At[4][2], B0[2][2], B1[2][2];
    const char* cA; const char* cB; S.ptrs(cur, cA, cB);
    PG8_STAGE(PG8_SB(0, 0), cB, voffB); PG8_STAGE(PG8_SB(0, 1), cB + hstepB, voffB); PG8_STAGE(PG8_SA(0, 0), cA, voffA); PG8_STAGE(PG8_SA(0, 1), cA + hstepA, voffA);
    if (wr == 1) PG8_BAR;
    PG8_WAIT_V(2); PG8_BAR;
    PG8_STAGE(PG8_SB(1, 0), cB + kstep, voffB); PG8_STAGE(PG8_SA(1, 0), cA + kstep, voffA); PG8_STAGE(PG8_SB(1, 1), cB + hstepB + kstep, voffB);
    PG8_WAIT_V(6); PG8_BAR;
    for (;;) {
        const bool has_next = S.next(ui + 1, nxt);
        const char* nA = cA; const char* nB = cB; if (has_next) S.ptrs(nxt, nA, nB);
        for (int t = 0; t < nt; t += 2) {
            const bool last = (t == nt - 2);
            const char* a1 = cA + (size_t)(t + 1) * kstep;
            const char* a2 = last ? nA : cA + (size_t)(t + 2) * kstep; const char* b2 = last ? nB : cB + (size_t)(t + 2) * kstep;
            const char* a3 = a2 + kstep; const char* b3 = b2 + kstep;
            PG8_LDB(B0, 0, 0); PG8_LDB(B1, 0, 1); PG8_SCHED; PG8_LDA(At, 0, 0); PG8_STAGE(PG8_SA(1, 1), a1 + hstepA, voffA);
            PG8_WAIT_V(8); PG8_WAIT_L(0); PG8_BAR; PG8_MMA(0, 0, At, B0); PG8_MMA(0, 1, At, B1); PG8_BAR; PG8_SCHED;
            PG8_LDA(At, 0, 1); PG8_STAGE(PG8_SB(0, 0), b2, voffB); PG8_STAGE(PG8_SB(0, 1), b2 + hstepB, voffB); PG8_STAGE(PG8_SA(0, 0), a2, voffA);
            PG8_WAIT_V(8); PG8_WAIT_L(0); PG8_BAR; PG8_MMA(1, 0, At, B0); PG8_MMA(1, 1, At, B1); PG8_BAR; PG8_SCHED;
            PG8_LDB(B0, 1, 0); PG8_LDB(B1, 1, 1); PG8_SCHED; PG8_LDA(At, 1, 0); PG8_STAGE(PG8_SA(0, 1), a2 + hstepA, voffA);
            PG8_WAIT_V(8); PG8_WAIT_L(0); PG8_BAR; PG8_MMA(0, 0, At, B0); PG8_MMA(0, 1, At, B1); PG8_BAR; PG8_SCHED;
            PG8_LDA(At, 1, 1); PG8_STAGE(PG8_SB(1, 0), b3, voffB); PG8_STAGE(PG8_SB(1, 1), b3 + hstepB, voffB); PG8_STAGE(PG8_SA(1, 0), a3, voffA);
            PG8_WAIT_V(8); PG8_WAIT_L(0); PG8_BAR; PG8_MMA(1, 0, At, B0); PG8_MMA(1, 1, At, B1); PG8_BAR; PG8_SCHED;
        }
        if (wr == 0) PG8_BAR;
        E(acc, cur, wr, wc, fr, fq);
        if (!has_next) break;
#pragma unroll
        for (int a = 0; a < 2; ++a)
#pragma unroll
            for (int b = 0; b < 2; ++b)
#pragma unroll
                for (int m = 0; m < 4; ++m)
#pragma unroll
                    for (int n = 0; n < 2; ++n) acc[a][b][m][n] = (f32x4){0.f, 0.f, 0.f, 0.f};
        cur = nxt; cA = nA; cB = nB; ++ui;
        if (wr == 1) PG8_BAR;
    }
    PG8_WAIT_V(0);
    PG8_BAR;
#undef PG8_SA
#undef PG8_SB
#undef PG8_STAGE
#undef PG8_LDA
#undef PG8_LDB
#undef PG8_MMA
#undef PG8_WAIT_V
#undef PG8_WAIT_L
#undef PG8_BAR
#undef PG8_SCHED
}
}
using pg8::Unit;
typedef f32x4 Acc[2][2][4][2];

struct SchedStatic {
    const bf16_t* A; const bf16_t* Bt; int lda, ldb, nM, nN, G, c;
    __device__ __forceinline__ bool next(int i, Unit& u) const { u.gi = 0; return pg8::static_tile(nM, nN, G, c, i, u.pm, u.pn); }
    __device__ __forceinline__ void ptrs(const Unit& u, const char*& a, const char*& b) const { a = (const char*)(A + (size_t)u.pm * 256 * lda); b = (const char*)(Bt + (size_t)u.pn * 256 * ldb); }
};
struct SchedGluRw {
    const bf16_t* Z; const bf16_t* YG; const bf16_t* WG; const bf16_t* WR; int nM, G, c;
    __device__ __forceinline__ bool next(int i, Unit& u) const { int pm, pn; if (!pg8::static_tile(nM, 4, G, c, i / 3, pm, pn)) return false; const int s = i % 3; u.pm = pm; u.gi = (s == 2) ? 1 : 0; u.pn = (s == 2) ? pn : 2 * pn + s; return true; }
    __device__ __forceinline__ void ptrs(const Unit& u, const char*& a, const char*& b) const {
        a = (const char*)((u.gi ? YG : Z) + (size_t)u.pm * 256 * 512); b = (const char*)((u.gi ? WR : WG) + (size_t)u.pn * 256 * 512); }
};
struct SchedS5 {
    const bf16_t* A; const bf16_t* Bt; size_t bstride; int ldb, nN, G, c;
    __device__ __forceinline__ bool next(int i, Unit& u) const { const int L = i * G + c; if (L >= 32 * 2 * nN) return false; u.pn = L % nN; const int r = L / nN; u.pm = r & 1; u.gi = r >> 1; return true; }
    __device__ __forceinline__ void ptrs(const Unit& u, const char*& a, const char*& b) const { a = (const char*)(A + ((size_t)u.gi * S5R + (size_t)u.pm * 256) * S5P); b = (const char*)(Bt + (size_t)u.gi * bstride + (size_t)u.pn * 256 * ldb); }
};

__device__ __forceinline__ void st16_wt(void* p, u32x4 v) { asm volatile("global_store_dwordx4 %0, %1, off sc1\n\ts_nop 1" :: "v"(p), "v"(v) : "memory"); }
#define EPI_ROWLOOP for (int ai = 0; ai < 2; ++ai) _Pragma("unroll") for (int m = 0; m < 4; ++m)
struct EpiProj {
    bf16_t* proj; const float* rstd1; bf16_t* U2;
    __device__ __forceinline__ void operator()(const Acc& acc, const Unit& u, int wr, int wc, int fr, int fq) const {
        const int colb = u.pn * 256 + wc * 32 + 8 * fq;
        float rs[8];
#pragma unroll
        for (int i = 0; i < 8; ++i) rs[i] = rstd1[u.pm * 256 + (i >> 2) * 128 + wr * 64 + (i & 3) * 16 + fr];
#pragma unroll
        EPI_ROWLOOP { const int row = u.pm * 256 + ai * 128 + wr * 64 + m * 16 + fr; const float r1 = rs[ai * 4 + m];
#pragma unroll
            for (int bj = 0; bj < 2; ++bj) { const int col = colb + bj * 128; const u32x4 w = pack8(acc[ai][bj][m][0] * r1, acc[ai][bj][m][1] * r1);
                if (col >= COL_U && col < COL_G1 && row < MP) { const int g = (col - COL_U) >> 4, c0 = (col - COL_U) & 15, b = row >> 11, t = row & 2047;
                    st16_wt(U2 + ((size_t)g * S5R + b * NCH + (t >> 5)) * S5P + (t & 31) * 16 + c0, w); }
                else st16_wt(proj + (size_t)row * INW + col, w); } }
    }
};
struct EpiBf {
    bf16_t* O; int ldc;
    __device__ __forceinline__ void operator()(const Acc& acc, const Unit& u, int wr, int wc, int fr, int fq) const {
        const int colb = u.pn * 256 + wc * 32 + 8 * fq;
#pragma unroll
        EPI_ROWLOOP { const int row = u.pm * 256 + ai * 128 + wr * 64 + m * 16 + fr; if (row < MV) {
#pragma unroll
            for (int bj = 0; bj < 2; ++bj) *(u32x4*)(O + (size_t)row * ldc + colb + bj * 128) = pack8(acc[ai][bj][m][0], acc[ai][bj][m][1]); } }
    }
};
struct EpiLora {
    bf16_t* O; const float* w0; const float* a0;
    __device__ __forceinline__ void operator()(const Acc& acc, const Unit& u, int wr, int wc, int fr, int fq) const {
        const int colb = u.pn * 256 + wc * 32 + 8 * fq;
#pragma unroll
        EPI_ROWLOOP { const int row = u.pm * 256 + ai * 128 + wr * 64 + m * 16 + fr; if (row < MV) {
#pragma unroll
            for (int bj = 0; bj < 2; ++bj) { const int col = colb + bj * 128; f32x4 v0 = acc[ai][bj][m][0], v1 = acc[ai][bj][m][1];
                if (col < 512) { v0 = sigm4(v0 + *(const f32x4*)(w0 + col)) * 0.6065306597126334f; v1 = sigm4(v1 + *(const f32x4*)(w0 + col + 4)) * 0.6065306597126334f; }
                else if (col < 1024) { v0 = sigm4(v0 + *(const f32x4*)(a0 + col - 512)); v1 = sigm4(v1 + *(const f32x4*)(a0 + col - 508)); }
                *(u32x4*)(O + (size_t)row * 1536 + col) = pack8(v0, v1); } } }
    }
};
struct EpiS5E {
    float* EE;
    __device__ __forceinline__ void operator()(const Acc& acc, const Unit& u, int wr, int wc, int fr, int fq) const {
        const int col = wc * 32 + 8 * fq;
#pragma unroll
        EPI_ROWLOOP { const int row = u.pm * 256 + ai * 128 + wr * 64 + m * 16 + fr; float* o = EE + ((size_t)u.gi * S5R + row) * 128 + col;
            *(f32x4*)o = acc[ai][0][m][0]; *(f32x4*)(o + 4) = acc[ai][0][m][1]; }
    }
};
struct EpiS5Y {
    bf16_t* Z; const bf16_t* U2; const float* Dsk;
    __device__ __forceinline__ void operator()(const Acc& acc, const Unit& u, int wr, int wc, int fr, int fq) const {
        const int g = u.gi;
        u32x4 pre[8][2]; f32x4 d0[2], d1[2];
#pragma unroll
        for (int bj = 0; bj < 2; ++bj) { const int col = u.pn * 256 + bj * 128 + wc * 32 + 8 * fq, c0 = col & 15; d0[bj] = *(const f32x4*)(Dsk + g * 16 + c0); d1[bj] = *(const f32x4*)(Dsk + g * 16 + c0 + 4);
#pragma unroll
            for (int i = 0; i < 8; ++i) { const int row = u.pm * 256 + (i >> 2) * 128 + wr * 64 + (i & 3) * 16 + fr; pre[i][bj] = *(const u32x4*)(U2 + ((size_t)g * S5R + row) * S5P + col); } }
#pragma unroll
        EPI_ROWLOOP { const int row = u.pm * 256 + ai * 128 + wr * 64 + m * 16 + fr; const int b = row >> 6, ch = row & 63;
#pragma unroll
            for (int bj = 0; bj < 2; ++bj) { const int col = u.pn * 256 + bj * 128 + wc * 32 + 8 * fq; const int t = col >> 4, c0 = col & 15;
                f32x4 u0, u1; unpack8(pre[ai * 4 + m][bj], u0, u1);
                const f32x4 y0 = gelu4(acc[ai][bj][m][0] + d0[bj] * u0), y1 = gelu4(acc[ai][bj][m][1] + d1[bj] * u1);
                *(u32x4*)(Z + ((size_t)(b * T + ch * Q + t)) * 512 + g * 16 + c0) = pack8(y0, y1); } }
    }
};
struct EpiGluRw {
    bf16_t* T1; bf16_t* MG; const bf16_t* proj;
    __device__ __forceinline__ void operator()(const Acc& acc, const Unit& u, int wr, int wc, int fr, int fq) const {
        if (u.gi == 0) { const int col = u.pn * 128 + wc * 32 + 8 * fq;
#pragma unroll
            EPI_ROWLOOP { const int row = u.pm * 256 + ai * 128 + wr * 64 + m * 16 + fr;
                f32x4 g0, g1; unpack8(LDNT(u32x4, proj + (size_t)row * INW + COL_G2 + col), g0, g1);
                const f32x4 s0 = sigm4(g0) * acc[ai][0][m][0] * sigm4(acc[ai][1][m][0]), s1 = sigm4(g1) * acc[ai][0][m][1] * sigm4(acc[ai][1][m][1]);
                *(u32x4*)(T1 + (size_t)row * D + col) = pack8(s0, s1); }
        } else {
#pragma unroll
            EPI_ROWLOOP { const int row = u.pm * 256 + ai * 128 + wr * 64 + m * 16 + fr;
#pragma unroll
                for (int bj = 0; bj < 2; ++bj) { const int col = u.pn * 256 + bj * 128 + wc * 32 + 8 * fq;
                    f32x4 g0, g1, t0, t1; unpack8(LDNT(u32x4, proj + (size_t)row * INW + COL_G1 + col), g0, g1); unpack8(*(const u32x4*)(T1 + (size_t)row * D + col), t0, t1);
                    *(u32x4*)(MG + (size_t)row * D + col) = pack8(sigm4(g0) * acc[ai][bj][m][0] + t0, sigm4(g1) * acc[ai][bj][m][1] + t1); } }
        }
    }
};
__device__ __forceinline__ float sq4(f32x4 v) { return (v[0] * v[0] + v[1] * v[1]) + (v[2] * v[2] + v[3] * v[3]); }
struct EpiRes1 {
    const float* xp; const float* xs; bf16_t* XB; float* ssq;
    __device__ __forceinline__ void operator()(const Acc& acc, const Unit& u, int wr, int wc, int fr, int fq) const {
#pragma unroll
        for (int ai = 0; ai < 2; ++ai) { f32x4 px[4][2][2];
#pragma unroll
            for (int m = 0; m < 4; ++m) { const float* src = xp + (size_t)(u.pm * 256 + ai * 128 + wr * 64 + m * 16 + fr) * D;
#pragma unroll
                for (int bj = 0; bj < 2; ++bj) { const int col = u.pn * 256 + bj * 128 + wc * 32 + 8 * fq; px[m][bj][0] = LDNT(f32x4, src + col); px[m][bj][1] = LDNT(f32x4, src + col + 4); } }
            float sm[4];
#pragma unroll
            for (int m = 0; m < 4; ++m) { const int row = u.pm * 256 + ai * 128 + wr * 64 + m * 16 + fr; float s = 0.f;
#pragma unroll
                for (int bj = 0; bj < 2; ++bj) { const int col = u.pn * 256 + bj * 128 + wc * 32 + 8 * fq;
                    const f32x4 v0 = px[m][bj][0] + acc[ai][bj][m][0], v1 = px[m][bj][1] + acc[ai][bj][m][1];
                    *(u32x4*)(XB + (size_t)row * D + col) = pack8(v0, v1); s += sq4(v0) + sq4(v1); }
                s += __shfl_xor(s, 16); s += __shfl_xor(s, 32); sm[m] = s; }
            atomicAdd(ssq + u.pm * 256 + ai * 128 + wr * 64 + fq * 16 + fr, fq == 0 ? sm[0] : fq == 1 ? sm[1] : fq == 2 ? sm[2] : sm[3]); }
    }
};
struct EpiRes2 {
    bf16_t* XB; float* ssq;
    __device__ __forceinline__ void operator()(const Acc& acc, const Unit& u, int wr, int wc, int fr, int fq) const {
        u32x4 pre[8][2];
#pragma unroll
        for (int i = 0; i < 8; ++i)
#pragma unroll
            for (int bj = 0; bj < 2; ++bj) pre[i][bj] = *(const u32x4*)(XB + (size_t)(u.pm * 256 + (i >> 2) * 128 + wr * 64 + (i & 3) * 16 + fr) * D + u.pn * 256 + bj * 128 + wc * 32 + 8 * fq);
#pragma unroll
        for (int ai = 0; ai < 2; ++ai) { float sm[4];
#pragma unroll
            for (int m = 0; m < 4; ++m) { const int row = u.pm * 256 + ai * 128 + wr * 64 + m * 16 + fr; float s = 0.f;
#pragma unroll
                for (int bj = 0; bj < 2; ++bj) { const int col = u.pn * 256 + bj * 128 + wc * 32 + 8 * fq;
                    f32x4 x0, x1; unpack8(pre[ai * 4 + m][bj], x0, x1);
                    const f32x4 v0 = x0 + acc[ai][bj][m][0], v1 = x1 + acc[ai][bj][m][1];
                    *(u32x4*)(XB + (size_t)row * D + col) = pack8(v0, v1); s += sq4(v0) + sq4(v1); }
                s += __shfl_xor(s, 16); s += __shfl_xor(s, 32); sm[m] = s; }
            atomicAdd(ssq + u.pm * 256 + ai * 128 + wr * 64 + fq * 16 + fr, fq == 0 ? sm[0] : fq == 1 ? sm[1] : fq == 2 ? sm[2] : sm[3]); }
    }
};
struct EpiF32 {
    float* O;
    __device__ __forceinline__ void operator()(const Acc& acc, const Unit& u, int wr, int wc, int fr, int fq) const {
#pragma unroll
        EPI_ROWLOOP { const int row = u.pm * 256 + ai * 128 + wr * 64 + m * 16 + fr;
#pragma unroll
            for (int bj = 0; bj < 2; ++bj) { float* o = O + (size_t)row * D + u.pn * 256 + bj * 128 + wc * 32 + 8 * fq; *(f32x4*)o = acc[ai][bj][m][0]; *(f32x4*)(o + 4) = acc[ai][bj][m][1]; } }
    }
};
struct EpiPle {
    float* X; const float* PE; const float* ssq3; float* ssqF;
    __device__ __forceinline__ void operator()(const Acc& acc, const Unit& u, int wr, int wc, int fr, int fq) const {
#pragma unroll
        EPI_ROWLOOP { const int row = u.pm * 256 + ai * 128 + wr * 64 + m * 16 + fr; float s = 0.f;
            if (row < MV) { const float rs = __builtin_amdgcn_rsqf(ssq3[row] * (1.0f / D) + EPS);
#pragma unroll
                for (int bj = 0; bj < 2; ++bj) { const int col = u.pn * 256 + bj * 128 + wc * 32 + 8 * fq; float* xr = X + (size_t)row * D + col; const float* pe = PE + (size_t)row * D + col;
                    const f32x4 v0 = *(const f32x4*)xr + sigm4(acc[ai][bj][m][0] * rs) * *(const f32x4*)pe, v1 = *(const f32x4*)(xr + 4) + sigm4(acc[ai][bj][m][1] * rs) * *(const f32x4*)(pe + 4);
                    *(f32x4*)xr = v0; *(f32x4*)(xr + 4) = v1; s += sq4(v0) + sq4(v1); } }
            s += __shfl_xor(s, 16); s += __shfl_xor(s, 32); if (fq == 0 && row < MV) atomicAdd(ssqF + row, s); }
    }
};
struct EpiPleFinal {
    float* X; const bf16_t* XB_; const bf16_t* PEB_; const float* ssq3; float* ssqF; unsigned* cnt; const float* fg;
    __device__ __forceinline__ void operator()(Acc& acc, const Unit& u, int wr, int wc, int fr, int fq) const {
        float rs3[8];
#pragma unroll
        for (int i = 0; i < 8; ++i) rs3[i] = ssq3[u.pm * 256 + (i >> 2) * 128 + wr * 64 + (i & 3) * 16 + fr];
#pragma unroll
        for (int ai = 0; ai < 2; ++ai) { u32x4 pp[4][2], px[4][2];
#pragma unroll
            for (int m = 0; m < 4; ++m) { const int row = u.pm * 256 + ai * 128 + wr * 64 + m * 16 + fr;
#pragma unroll
                for (int bj = 0; bj < 2; ++bj) { const int col = u.pn * 256 + bj * 128 + wc * 32 + 8 * fq; pp[m][bj] = LDNT(u32x4, PEB_ + (size_t)row * D + col); px[m][bj] = LDNT(u32x4, XB_ + (size_t)row * D + col); } }
            float sm[4];
#pragma unroll
            for (int m = 0; m < 4; ++m) { float s = 0.f; const float rs = __builtin_amdgcn_rsqf(rs3[ai * 4 + m] * (1.0f / D) + EPS);
#pragma unroll
                for (int bj = 0; bj < 2; ++bj) {
                    f32x4 p0, p1, x0, x1; unpack8(pp[m][bj], p0, p1); unpack8(px[m][bj], x0, x1);
                    const f32x4 v0 = x0 + sigm4(acc[ai][bj][m][0] * rs) * p0, v1 = x1 + sigm4(acc[ai][bj][m][1] * rs) * p1;
                    acc[ai][bj][m][0] = v0; acc[ai][bj][m][1] = v1; s += sq4(v0) + sq4(v1); }
                s += __shfl_xor(s, 16); s += __shfl_xor(s, 32); sm[m] = s; }
            atomicAdd(ssqF + u.pm * 256 + ai * 128 + wr * 64 + fq * 16 + fr, fq == 0 ? sm[0] : fq == 1 ? sm[1] : fq == 2 ? sm[2] : sm[3]); }
        asm volatile("s_waitcnt vmcnt(0)" ::: "memory"); __builtin_amdgcn_s_barrier(); asm volatile("" ::: "memory");
        if (threadIdx.x == 0) { unsigned* c = cnt + 64 * u.pm; __hip_atomic_fetch_add(c, 1u, __ATOMIC_RELAXED, __HIP_MEMORY_SCOPE_AGENT);
            unsigned sp = 0; while (__hip_atomic_load(c, __ATOMIC_RELAXED, __HIP_MEMORY_SCOPE_AGENT) < 4u) { __builtin_amdgcn_s_sleep(1); if (++sp > (1u << 20)) break; } }
        asm volatile("s_waitcnt vmcnt(0) lgkmcnt(0)" ::: "memory"); __builtin_amdgcn_s_barrier(); asm volatile("" ::: "memory");
        { float rsf[8]; f32x4 g0[2], g1[2];
#pragma unroll
          for (int i = 0; i < 8; ++i) rsf[i] = __hip_atomic_load(ssqF + u.pm * 256 + (i >> 2) * 128 + wr * 64 + (i & 3) * 16 + fr, __ATOMIC_RELAXED, __HIP_MEMORY_SCOPE_AGENT);
#pragma unroll
          for (int bj = 0; bj < 2; ++bj) { const int col = u.pn * 256 + bj * 128 + wc * 32 + 8 * fq; g0[bj] = *(const f32x4*)(fg + col); g1[bj] = *(const f32x4*)(fg + col + 4); }
#pragma unroll
          EPI_ROWLOOP { const int row = u.pm * 256 + ai * 128 + wr * 64 + m * 16 + fr; const float rs = __builtin_amdgcn_rsqf(rsf[ai * 4 + m] * (1.0f / D) + EPS);
#pragma unroll
            for (int bj = 0; bj < 2; ++bj) { const int col = u.pn * 256 + bj * 128 + wc * 32 + 8 * fq; float* xr = X + (size_t)row * D + col;
                *(f32x4*)xr = acc[ai][bj][m][0] * rs * g0[bj]; *(f32x4*)(xr + 4) = acc[ai][bj][m][1] * rs * g1[bj]; } } }
    }
};
struct SchedTail {
    const bf16_t* A; const bf16_t* Bt; int lda, ldb, first, nidle, nunits, nN, c;
    __device__ __forceinline__ bool next(int i, Unit& u) const { if (c < first) return false; const int L = i * nidle + (c - first); if (L >= nunits) return false; u.pm = L / nN; u.pn = L % nN; u.gi = 0; return true; }
    __device__ __forceinline__ void ptrs(const Unit& u, const char*& a, const char*& b) const { a = (const char*)(A + (size_t)u.pm * 256 * lda); b = (const char*)(Bt + (size_t)u.pn * 256 * ldb); }
};
struct EpiFfn {
    bf16_t* HG; const float* ssq2; const float* cw; const float* cb; float* SA; float* SB; const float* stc; float* out; LAS float* halo;
    __device__ __forceinline__ void operator()(Acc& acc, const Unit& u, int wr, int wc, int fr, int fq) const {
        const int cl = wc * 32 + 8 * fq, col = u.pn * 128 + cl;
#pragma unroll
        EPI_ROWLOOP { const int row = u.pm * 256 + ai * 128 + wr * 64 + m * 16 + fr; const float rs = __builtin_amdgcn_rsqf(ssq2[row < MV ? row : 0] * (1.0f / D) + EPS);
#pragma unroll
            for (int bj = 0; bj < 2; ++bj) { acc[ai][bj][m][0] *= rs; acc[ai][bj][m][1] *= rs; } }
        if (u.pm == 64) {
#pragma unroll
            for (int m = 0; m < 4; ++m) { const int r = wr * 64 + m * 16 + fr;
#pragma unroll
                for (int n = 0; n < 2; ++n) { const int c4 = col + 4 * n; const float* s0 = stc + ((size_t)r * 2) * DFF + c4;
                    const f32x4 p2 = *(const f32x4*)s0, p1 = *(const f32x4*)(s0 + DFF), a0 = acc[0][0][m][n];
                    const f32x4 cv = *(const f32x4*)(cw + c4) * p2 + *(const f32x4*)(cw + DFF + c4) * p1 + *(const f32x4*)(cw + 2 * DFF + c4) * a0 + *(const f32x4*)(cb + c4);
                    const f32x4 hv = gelu4(cv) * acc[0][1][m][n]; u32x2 w; w.x = cvt_pk_bf16(hv[0], hv[1]); w.y = cvt_pk_bf16(hv[2], hv[3]);
                    *(u32x2*)(HG + (size_t)(MP + r) * DFF + c4) = w;
                    float* o = out + O_SCONV + ((size_t)r * 2) * DFF + c4; *(f32x4*)o = p1; *(f32x4*)(o + DFF) = a0; }
                asm volatile("" ::: "memory"); }
            __builtin_amdgcn_s_barrier();
            return;
        }
#pragma unroll
        for (int ai = 0; ai < 2; ++ai) if (fr >= 14) { LAS float* h = halo + ((2 * ai + wr) * 2 + (fr - 14)) * 128 + cl; *(LAS f32x4*)h = acc[ai][0][3][0]; *(LAS f32x4*)(h + 4) = acc[ai][0][3][1]; }
        if (wr == 0 && fr < 2) { float* s = SA + ((size_t)u.pm * 4 + fr) * DFF + col; *(f32x4*)s = acc[0][0][0][0]; *(f32x4*)(s + 4) = acc[0][0][0][1];
            float* sb = SB + ((size_t)u.pm * 2 + fr) * DFF + col; *(f32x4*)sb = acc[0][1][0][0]; *(f32x4*)(sb + 4) = acc[0][1][0][1]; }
        if (wr == 1 && fr >= 14) { float* s = SA + ((size_t)u.pm * 4 + 2 + (fr - 14)) * DFF + col; *(f32x4*)s = acc[1][0][3][0]; *(f32x4*)(s + 4) = acc[1][0][3][1];
            if ((u.pm & 7) == 7) { float* o = out + O_PCONV + ((size_t)(u.pm >> 3) * 2 + (fr - 14)) * DFF + col; *(f32x4*)o = acc[1][0][3][0]; *(f32x4*)(o + 4) = acc[1][0][3][1]; } }
        asm volatile("s_waitcnt lgkmcnt(0)" ::: "memory"); __builtin_amdgcn_s_barrier(); asm volatile("" ::: "memory");
        const int loff = fr * DFF + col;
#pragma unroll
        for (int ai = 0; ai < 2; ++ai) { const int seg = 2 * ai + wr;
#pragma unroll
            for (int n = 0; n < 2; ++n) { const int c4 = col + 4 * n;
                const f32x4 w0 = *(const f32x4*)(cw + c4), w1 = *(const f32x4*)(cw + DFF + c4), w2 = *(const f32x4*)(cw + 2 * DFF + c4), bb = *(const f32x4*)(cb + c4);
                f32x4 h0 = (f32x4){0.f, 0.f, 0.f, 0.f}, h1 = h0;
                if (seg > 0) { const LAS float* h = halo + ((seg - 1) * 2) * 128 + cl + 4 * n; h0 = *(const LAS f32x4*)h; h1 = *(const LAS f32x4*)(h + 128); }
#pragma unroll
                for (int m = 0; m < 4; ++m) { bf16_t* rowbase = HG + (size_t)(u.pm * 256 + ai * 128 + wr * 64 + m * 16) * DFF + 4 * n;
                    f32x4 cv;
#pragma unroll
                    for (int e = 0; e < 4; ++e) { const float a = acc[ai][0][m][n][e];
                        float q1, q2;
                        if (m > 0) { const float mir = dppf<0x140>(acc[ai][0][m - 1][n][e]); q1 = mir; q2 = dppf<0xB1>(mir); }
                        else { q1 = h1[e]; q2 = fr == 0 ? h0[e] : h1[e]; }
                        const float p1 = __builtin_bit_cast(float, __builtin_amdgcn_update_dpp(__builtin_bit_cast(int, q1), __builtin_bit_cast(int, a), 0x111, 0xf, 0xf, false));
                        const float p2 = __builtin_bit_cast(float, __builtin_amdgcn_update_dpp(__builtin_bit_cast(int, q2), __builtin_bit_cast(int, a), 0x112, 0xf, 0xf, false));
                        cv[e] = w0[e] * p2 + w1[e] * p1 + w2[e] * a + bb[e]; }
                    const f32x4 hv = gelu4(cv) * acc[ai][1][m][n]; u32x2 w; w.x = cvt_pk_bf16(hv[0], hv[1]); w.y = cvt_pk_bf16(hv[2], hv[3]);
                    *(u32x2*)(rowbase + loff) = w; }
                asm volatile("" ::: "memory"); } }
    }
};

#define XB_TMO      128
#define XB_XCNT(j)  (256  + 64 * (j))
#define XB_XSUB(j)  (1280 + 64 * (j))
#define XB_XGEN(j)  (2304 + 64 * (j))
#define XB_TOP      3328
#define XB_TOPGEN   3392
#define XCD_BAR_WORDS 3456
#define XB_SPIN_CAP (1u << 18)
__device__ __forceinline__ unsigned xb_ld(unsigned* p)              { return __hip_atomic_load(p, __ATOMIC_RELAXED, __HIP_MEMORY_SCOPE_AGENT); }
__device__ __forceinline__ unsigned xb_add(unsigned* p, unsigned v) { return __hip_atomic_fetch_add(p, v, __ATOMIC_RELAXED, __HIP_MEMORY_SCOPE_AGENT); }
__device__ __forceinline__ unsigned xb_xcc_id() { return (unsigned)__builtin_amdgcn_s_getreg((3 << 11) | 20) & 0xFu; }
#define XB_SPIN(cond, bar) do { unsigned _sp = 0; while (cond) { __builtin_amdgcn_s_sleep(1); \
    if ((++_sp & 255u) == 0u) { if (xb_ld(&(bar)[XB_TMO])) break; if (_sp > XB_SPIN_CAP) { atomicAdd(&(bar)[XB_TMO], 1u); break; } } } } while (0)
struct XcdBarrier { unsigned* bar; unsigned x; volatile LAS unsigned* st; };
__device__ __forceinline__ void xcd_barrier_complete(unsigned* bar, unsigned x, unsigned& nloc, unsigned& nx) {
    const unsigned G = gridDim.x * gridDim.y * gridDim.z;
    unsigned sum, cnt, mine, sp = 0u;
    for (;;) {
        sum = 0u; cnt = 0u; mine = 0u;
#pragma unroll
        for (unsigned j = 0; j < 16; ++j) { const unsigned c = xb_ld(&bar[XB_XCNT(j)]); sum += c; cnt += (c > 0u) ? 1u : 0u; mine = (j == x) ? c : mine; }
        if (sum == G) break;
        __builtin_amdgcn_s_sleep(1);
        if ((++sp & 255u) == 0u) { if (xb_ld(&bar[XB_TMO])) break; if (sp > XB_SPIN_CAP) { atomicAdd(&bar[XB_TMO], 1u); break; } }
    }
    nloc = mine > 0u ? mine : 1u; nx = cnt > 0u ? cnt : 1u;
}
__device__ __forceinline__ void xcd_barrier(const XcdBarrier& b) {
    asm volatile("s_waitcnt vmcnt(0)" ::: "memory");
    __syncthreads();
    if (threadIdx.x == 0) {
        unsigned* bar = b.bar;
        __builtin_amdgcn_s_waitcnt(0);
        unsigned nloc = b.st[0], nx = b.st[1];
        if (nloc == 0u) { xcd_barrier_complete(bar, b.x, nloc, nx); b.st[0] = nloc; b.st[1] = nx; }
        const unsigned old = xb_add(&bar[XB_XSUB(b.x)], 1u);
        const unsigned gen = old / nloc;
        if (old + 1u == (gen + 1u) * nloc) {
            __builtin_amdgcn_fence(__ATOMIC_RELEASE, "agent");
            asm volatile("s_waitcnt vmcnt(0)" ::: "memory");
            const unsigned og = xb_add(&bar[XB_TOP], 1u);
            const unsigned tg = og / nx;
            if (og + 1u == (tg + 1u) * nx) xb_add(&bar[XB_TOPGEN], 1u);
            else XB_SPIN(xb_ld(&bar[XB_TOPGEN]) == tg, bar);
            __builtin_amdgcn_fence(__ATOMIC_ACQUIRE, "agent");
            xb_add(&bar[XB_XGEN(b.x)], 1u);
            asm volatile("s_waitcnt vmcnt(0)" ::: "memory");
        } else {
            XB_SPIN(xb_ld(&bar[XB_XGEN(b.x)]) == gen, bar);
            __builtin_amdgcn_fence(__ATOMIC_ACQUIRE, "agent");
            asm volatile("s_waitcnt vmcnt(0)" ::: "memory");
        }
    }
    __syncthreads();
}

__device__ __forceinline__ f32x4 skinny_part(const bf16_t* A, int lda, const bf16_t* Bt, int ldb, int k0, int klen, int fr, int fq) {
    const bf16_t* ap = A + (size_t)fr * lda + fq * 8 + k0; const bf16_t* bp = Bt + (size_t)fr * ldb + fq * 8 + k0;
    f32x4 acc = (f32x4){0.f, 0.f, 0.f, 0.f};
#pragma unroll 11
    for (int k = 0; k < klen; k += 32) { const bf16x8 a0 = *(const bf16x8*)(ap + k), b0 = *(const bf16x8*)(bp + k); acc = __builtin_amdgcn_mfma_f32_16x16x32_bf16(b0, a0, acc, 0, 0, 0); }
    return acc;
}
__device__ __forceinline__ void skinny_put(LAS f32x4* red, int slot, int wave, int lane, f32x4 v) { red[(slot * 8 + wave) * 64 + lane] = v; }
__device__ __forceinline__ f32x4 skinny_get(const LAS f32x4* red, int slot, int lane) { f32x4 v = red[(slot * 8) * 64 + lane];
#pragma unroll
    for (int w = 1; w < 8; ++w) v += red[(slot * 8 + w) * 64 + lane];
    return v; }
__device__ __forceinline__ u32x2 pack4(f32x4 v) { u32x2 w; w.x = cvt_pk_bf16(v[0], v[1]); w.y = cvt_pk_bf16(v[2], v[3]); return w; }

struct Args { const float* in[42]; float* out; unsigned char* ws; };
struct Frame {
    LAS unsigned char* lds; int tid, lane, wave, G, c;
    const float* const* in; float* out; unsigned char* ws;
};
typedef const __attribute__((address_space(4))) unsigned long long* KAP;
typedef __attribute__((address_space(1))) unsigned char* GPTR;
#define IN(k) ((const float*)(GPTR)ka[k])
enum { I_XP = 0, I_XS, I_PP, I_PS, I_SSHIFT, I_SWKV, I_SSRE, I_SSIM, I_SCONV, I_LN1, I_WIN, I_MU, I_W0, I_W2, I_A0, I_A2, I_G2, I_KK, I_KA, I_RK, I_LNXG, I_LNXB, I_WRW,
       I_ARE, I_AIM, I_LOGDT, I_BRE, I_BIM, I_CRE, I_CIM, I_DSK, I_WGLU, I_WOUT, I_LN2, I_WFFI, I_CW, I_CB, I_WFFO, I_LN3, I_WPG, I_WPLE, I_FG };

__device__ __forceinline__ void transpose_item(const float* W, const float* g, int K, int N, bf16_t* WT, int ldk, int koff, int row_off, int half, LAS float* scr, int item, int lane) {
    const int nblk = N / 32, kb = item / nblk, nb = item % nblk, k0 = 64 * kb, n0 = 32 * nb;
#pragma unroll 8
    for (int i = 0; i < 32; ++i) { const int kk = 2 * i + (lane >> 5); float v = __builtin_nontemporal_load(&W[(size_t)(k0 + kk) * N + n0 + (lane & 31)]); if (g) v *= g[k0 + kk]; scr[kk * 33 + (lane & 31)] = v; }
    asm volatile("s_waitcnt lgkmcnt(0)" ::: "memory");
    const int c = lane & 7;
    int rbase = row_off + n0;
    if (half > 0) { const int h = n0 / half, np = n0 % half; rbase = (np / 128) * 256 + h * 128 + (np % 128); }
#pragma unroll
    for (int j = 0; j < 4; ++j) { const int n = (lane >> 3) + 8 * j; const LAS float* s = scr + (8 * c) * 33 + n;
        u32x4 o; o.x = cvt_pk_bf16(s[0 * 33], s[1 * 33]); o.y = cvt_pk_bf16(s[2 * 33], s[3 * 33]); o.z = cvt_pk_bf16(s[4 * 33], s[5 * 33]); o.w = cvt_pk_bf16(s[6 * 33], s[7 * 33]);
        *(u32x4*)(WT + (size_t)(rbase + n) * ldk + koff + k0 + 8 * c) = o; }
    asm volatile("s_waitcnt lgkmcnt(0)" ::: "memory");
}

__global__ void __launch_bounds__(NT, 2) fwd(Args args) {
    extern __shared__ __attribute__((aligned(16))) unsigned char lds_raw[];
    LAS unsigned char* lds = (LAS unsigned char*)lds_raw;
#define PH_BEGIN int tid = (int)threadIdx.x; asm volatile("" : "+v"(tid)); const int lane = tid & 63, wave = __builtin_amdgcn_readfirstlane(tid >> 6); \
    int G = gridDim.x; asm volatile("" : "+s"(G)); int cu = blockIdx.x; asm volatile("" : "+s"(cu)); const int NGW = G * NWAVES, NGT = G * NT; (void)NGW; (void)NGT; \
    const int gw = cu * NWAVES + wave, gt = cu * NT + tid; (void)gw; (void)gt; (void)lane; \
    KAP ka = (KAP)__builtin_amdgcn_kernarg_segment_ptr(); asm volatile("" : "+s"(ka)); \
    unsigned char* ws = (unsigned char*)(GPTR)ka[43]; unsigned char* outb = (unsigned char*)(GPTR)ka[42]; float* out = (float*)outb; (void)out;
#define GSYNC() do { KAP ka2 = (KAP)__builtin_amdgcn_kernarg_segment_ptr(); asm volatile("" : "+s"(ka2)); \
    XcdBarrier bb_; bb_.bar = (unsigned*)((unsigned char*)(GPTR)ka2[43] + SM_BAR); bb_.x = xb_xcc_id(); bb_.st = (volatile LAS unsigned*)(lds + XLDS_OFF + 8192); xcd_barrier(bb_); } while (0)
#define WT_IN ((bf16_t*)(ws + WS_WT_IN))
#define WT_LORA ((bf16_t*)(ws + WS_WT_LORA))
#define WT_RW ((bf16_t*)(ws + WS_WT_RW))
#define WT_GLU ((bf16_t*)(ws + WS_WT_GLU))
#define WT_OUT ((bf16_t*)(ws + WS_WT_OUT))
#define WT_FFI ((bf16_t*)(ws + WS_WT_FFI))
#define WT_FFO ((bf16_t*)(ws + WS_WT_FFO))
#define WT_PG ((bf16_t*)(ws + WS_WT_PG))
#define WT_PLE ((bf16_t*)(ws + WS_WT_PLE))
#define RSTD1 ((float*)(ws + SM_RSTD1))
#define SSQ2 ((float*)(ws + SM_SSQ2))
#define SSQ3 ((float*)(ws + SM_SSQ3))
#define SSQF ((float*)(ws + SM_SSQF))
#define BONUS ((float*)(ws + SM_BONUS))
#define SA ((float*)(ws + SM_SA))
#define SB ((float*)(ws + SM_SB))
#define PBF ((bf16_t*)(ws + WS_PBF))
#define BTY ((bf16_t*)(ws + S5_BTY))
#define WSB ((bf16_t*)(ws + S5_WSB))
#define U2 ((bf16_t*)(ws + S5_U2))
#define EE ((float*)(ws + S5_EE))
#define YG ((bf16_t*)(ws + WS_YG))
#define XN ((bf16_t*)(ws + WS_RA))
#define LIN ((bf16_t*)(ws + WS_RA))
#define YWKV ((bf16_t*)(ws + WS_RA))
#define MG ((bf16_t*)(ws + WS_RA))
#define PROJ ((bf16_t*)(ws + WS_PROJ))
#define XB ((bf16_t*)(ws + WS_XB))
#define HG ((bf16_t*)(ws + WS_HG))
#define PEB ((bf16_t*)(ws + WS_RA))
#define LO ((bf16_t*)(outb + DO_LO))
#define ZB ((bf16_t*)(outb + DO_Z))
#define T1 ((bf16_t*)(outb + DO_T1))
#define X out

    if (threadIdx.x < 2) ((volatile LAS unsigned*)(lds + XLDS_OFF + 8192))[threadIdx.x] = 0u;
    { KAP ka2 = (KAP)__builtin_amdgcn_kernarg_segment_ptr(); asm volatile("" : "+s"(ka2)); if (threadIdx.x == 0) (void)xb_add((unsigned*)((unsigned char*)(GPTR)ka2[43] + SM_BAR) + XB_XCNT(xb_xcc_id()), 1u); }
    __syncthreads();
    {
        PH_BEGIN
        for (int rep = 0; rep < REP_P0; ++rep) {
        __syncthreads();
        LAS float* scr = (LAS float*)(lds + wave * 16384);
        constexpr int I_IN = (D / 64) * (INW / 32), I_RWW = (512 / 64) * (D / 32), I_GL = (512 / 64) * (2048 / 32), I_L64 = 16, I_L128 = 32;
        constexpr int NITEMS = I_IN + I_RWW + I_GL + 2 * I_L64 + I_L128;
        for (int it = gw; it < NITEMS; it += NGW) {
            int r = it;
            if (r < I_IN) { transpose_item(IN(I_WIN), IN(I_LN1), D, INW, WT_IN, D, 0, 0, 0, scr, r, lane); continue; } r -= I_IN;
            if (r < I_RWW) { transpose_item(IN(I_WRW), nullptr, 512, D, WT_RW, 512, 0, 0, 0, scr, r, lane); continue; } r -= I_RWW;
            if (r < I_GL) { transpose_item(IN(I_WGLU), nullptr, 512, 2048, WT_GLU, 512, 0, 0, 1024, scr, r, lane); continue; } r -= I_GL;
            if (r < I_L64) { transpose_item(IN(I_W2), nullptr, 64, 512, WT_LORA, 256, 0, 0, 0, scr, r, lane); continue; } r -= I_L64;
            if (r < I_L64) { transpose_item(IN(I_A2), nullptr, 64, 512, WT_LORA, 256, 64, 512, 0, scr, r, lane); continue; } r -= I_L64;
            transpose_item(IN(I_G2), nullptr, 128, 512, WT_LORA, 256, 128, 1024, 0, scr, r, lane);
        }
        for (int i = gt; i < 1536 * 32; i += NGT) { const int n = i >> 5, k = (i & 31) * 8; const bool nz = (n < 512) ? (k < 64) : (n < 1024 ? (k >= 64 && k < 128) : (k >= 128));
            if (!nz) *(u32x4*)(WT_LORA + (size_t)n * 256 + k) = (u32x4){0u, 0u, 0u, 0u}; }
#pragma unroll 2
        for (int m = gw; m < M; m += NGW) {
            u32x2* o = (u32x2*)(XN + (size_t)m * D) + lane;
            if (m < MV) { const float* xr = m < MP ? IN(I_XP) + (size_t)m * D : IN(I_XS) + (size_t)(m - MP) * D; float s = 0.f;
#pragma unroll
                for (int j = 0; j < 4; ++j) { const f32x4 v = LDNT(f32x4, (const f32x4*)xr + lane + 64 * j); s += sq4(v); u32x2 w; w.x = cvt_pk_bf16(v[0], v[1]); w.y = cvt_pk_bf16(v[2], v[3]); o[64 * j] = w; }
                s = wave_sum(s); if (lane == 0) RSTD1[m] = __builtin_amdgcn_rsqf(s * (1.0f / D) + EPS);
                const float* pr = m < MP ? IN(I_PP) + (size_t)m * PLE : IN(I_PS) + (size_t)(m - MP) * PLE; const f32x4 pv = LDNT(f32x4, (const f32x4*)pr + lane);
                u32x2 w; w.x = cvt_pk_bf16(pv[0], pv[1]); w.y = cvt_pk_bf16(pv[2], pv[3]); *((u32x2*)(PBF + (size_t)m * PLE) + lane) = w;
            } else {
#pragma unroll
                for (int j = 0; j < 4; ++j) o[64 * j] = (u32x2){0u, 0u};
                if (lane == 0) RSTD1[m] = 1.0f; *((u32x2*)(PBF + (size_t)m * PLE) + lane) = (u32x2){0u, 0u};
            }
            if (lane == 0) { SSQ2[m] = 0.f; SSQ3[m] = 0.f; SSQF[m] = 0.f; }
        }
        {
            LAS float* Xr = (LAS float*)(lds + wave * 16384); LAS float* Xi = Xr + 1024; LAS float* Kt = Xi + 1024;
            for (int it2 = gw; it2 < 2 * 32 * 32; it2 += NGW) { if (it2 & 1) continue; const int it = it2 >> 1;
                const int g = it >> 5, tau = it & 31, n = lane;
                const float dt = expf(IN(I_LOGDT)[g]); const float lr = IN(I_ARE)[g * 64 + n], li = IN(I_AIM)[g * 64 + n];
                float sn, cs; const float mg = expf(lr * dt * tau); sincosf(li * dt * tau, &sn, &cs); const float pr = mg * cs, pi = mg * sn;
                const float mg1 = expf(lr * dt * (tau + 1)); sincosf(li * dt * (tau + 1), &sn, &cs); const float p1r = mg1 * cs, p1i = mg1 * sn;
                const float m1 = expf(lr * dt); sincosf(li * dt, &sn, &cs); const float ar = m1 * cs, ai = m1 * sn, den = lr * lr + li * li;
                const float fr_ = ((ar - 1.0f) * lr + ai * li) / den, fi_ = (ai * lr - (ar - 1.0f) * li) / den;
                { const float* brp = IN(I_BRE) + (size_t)(g * 64 + n) * 16; const float* bip = IN(I_BIM) + (size_t)(g * 64 + n) * 16; const int sidx = 31 - tau;
                  unsigned wre[8], wim[8];
#pragma unroll
                  for (int c4 = 0; c4 < 4; ++c4) { const f32x4 br = *(const f32x4*)(brp + 4 * c4), bi = *(const f32x4*)(bip + 4 * c4); f32x4 xr, xi;
#pragma unroll
                      for (int e = 0; e < 4; ++e) { const float bbr = fr_ * br[e] - fi_ * bi[e], bbi = fr_ * bi[e] + fi_ * br[e]; xr[e] = pr * bbr - pi * bbi; xi[e] = pr * bbi + pi * bbr; }
                      *(LAS f32x4*)(Xr + n * 16 + 4 * c4) = xr; *(LAS f32x4*)(Xi + n * 16 + 4 * c4) = xi;
                      wre[2 * c4] = cvt_pk_bf16(xr[0], xr[1]); wre[2 * c4 + 1] = cvt_pk_bf16(xr[2], xr[3]); wim[2 * c4] = cvt_pk_bf16(xi[0], xi[1]); wim[2 * c4 + 1] = cvt_pk_bf16(xi[2], xi[3]); }
                  bf16_t* wsr = WSB + ((size_t)g * 128 + n) * S5K + sidx * 16; bf16_t* wsi = wsr + (size_t)64 * S5K;
                  *(u32x4*)wsr = (u32x4){wre[0], wre[1], wre[2], wre[3]}; *(u32x4*)(wsr + 8) = (u32x4){wre[4], wre[5], wre[6], wre[7]};
                  *(u32x4*)wsi = (u32x4){wim[0], wim[1], wim[2], wim[3]}; *(u32x4*)(wsi + 8) = (u32x4){wim[4], wim[5], wim[6], wim[7]}; }
#pragma unroll 4
                for (int c = 0; c < 16; ++c) { const float cr = IN(I_CRE)[(size_t)(g * 16 + c) * 64 + n], ci = IN(I_CIM)[(size_t)(g * 16 + c) * 64 + n];
                    bf16_t* o = BTY + ((size_t)g * 512 + tau * 16 + c) * S5P + 512 + n; const unsigned w = cvt_pk_bf16(cr * p1r - ci * p1i, -(cr * p1i + ci * p1r)); o[0] = (bf16_t)(w & 0xffff); o[64] = (bf16_t)(w >> 16); }
                asm volatile("s_waitcnt lgkmcnt(0)" ::: "memory");
                { const int c = lane >> 2, cq = (lane & 3) * 4; const float* crp = IN(I_CRE) + (size_t)(g * 16 + c) * 64; const float* cip = IN(I_CIM) + (size_t)(g * 16 + c) * 64; f32x4 acc = (f32x4){0.f, 0.f, 0.f, 0.f};
#pragma unroll 4
                  for (int nn = 0; nn < 64; nn += 4) { const f32x4 cr = *(const f32x4*)(crp + nn), ci = *(const f32x4*)(cip + nn);
#pragma unroll
                      for (int e = 0; e < 4; ++e) { const f32x4 xr = *(const LAS f32x4*)(Xr + (nn + e) * 16 + cq), xi = *(const LAS f32x4*)(Xi + (nn + e) * 16 + cq); acc += xr * cr[e] - xi * ci[e]; } }
                  *(LAS f32x4*)(Kt + c * 16 + cq) = acc; }
                asm volatile("s_waitcnt lgkmcnt(0)" ::: "memory");
                for (int idx = lane; idx < (32 - tau) * 32; idx += 64) { const int blk = idx >> 5, rc = (idx & 31) >> 1, hf = idx & 1; const LAS float* kp = Kt + rc * 16 + hf * 8;
                    u32x4 w; w.x = cvt_pk_bf16(kp[0], kp[1]); w.y = cvt_pk_bf16(kp[2], kp[3]); w.z = cvt_pk_bf16(kp[4], kp[5]); w.w = cvt_pk_bf16(kp[6], kp[7]);
                    *(u32x4*)(BTY + ((size_t)g * 512 + (tau + blk) * 16 + rc) * S5P + blk * 16 + hf * 8) = w;
                    if (tau > 0) *(u32x4*)(BTY + ((size_t)g * 512 + blk * 16 + rc) * S5P + (tau + blk) * 16 + hf * 8) = (u32x4){0u, 0u, 0u, 0u}; }
                asm volatile("s_waitcnt lgkmcnt(0)" ::: "memory");
            }
        }
        }
    }
    GSYNC();

    {
        PH_BEGIN
        SchedStatic S{XN, WT_IN, D, D, 65, 17, G, cu}; EpiProj E{PROJ, RSTD1, U2};
        for (int rep = 0; rep < REP_P1; ++rep) pg8::gemm_phase(lds, D, D, D, S, E);
    }
    GSYNC();

    {
        PH_BEGIN
        const float* mu = IN(I_MU);
        const int skipc = (G >= 256) ? 64 : 0, gt2 = (cu - skipc) * NT + tid, NGT2 = (G - skipc) * NT;
        for (int i = gt2; i >= 0 && i < M * 32; i += NGT2) { const int m = i >> 5, q = i & 31, j0 = 1536 + 8 * q; u32x4 w = (u32x4){0u, 0u, 0u, 0u};
            if (m < MV) { f32x4 p0, p1, r0, r1; unpack8(*(const u32x4*)(PROJ + (size_t)m * INW + j0), p0, p1);
                if (m >= MP) { const float* s = IN(I_SSHIFT) + (size_t)(m - MP) * SHW + j0; r0 = *(const f32x4*)s; r1 = *(const f32x4*)(s + 4); }
                else if ((m & 2047) == 0) { r0 = (f32x4){0.f, 0.f, 0.f, 0.f}; r1 = r0; }
                else unpack8(*(const u32x4*)(PROJ + (size_t)(m - 1) * INW + j0), r0, r1);
                const f32x4 m0 = *(const f32x4*)(mu + j0), m1 = *(const f32x4*)(mu + j0 + 4);
                f32x4 x0 = p0 + (r0 - p0) * m0, x1 = p1 + (r1 - p1) * m1;
                if (q < 8) { x0 = (f32x4){ftanh(x0[0]), ftanh(x0[1]), ftanh(x0[2]), ftanh(x0[3])}; x1 = (f32x4){ftanh(x1[0]), ftanh(x1[1]), ftanh(x1[2]), ftanh(x1[3])}; }
                else if (q >= 16) { x0 = sigm4(x0); x1 = sigm4(x1); }
                w = pack8(x0, x1); }
            *(u32x4*)(LIN + (size_t)m * 256 + 8 * q) = w; }
        for (int i = gt2; i >= 0 && i < (8 + 128) * SHW; i += NGT2) { const int r = i / SHW, j = i % SHW;
            if (r < 8) out[O_PSHIFT + (size_t)r * SHW + j] = bf1(PROJ[(size_t)(r * T + T - 1) * INW + j]); else out[O_SSHIFT + (size_t)(r - 8) * SHW + j] = bf1(PROJ[(size_t)(MP + r - 8) * INW + j]); }
        if (cu >= skipc) {
            LAS float* scr = (LAS float*)(lds + wave * 16384);
            constexpr int I_O2 = (D / 64) * (D / 32), I_FO2 = (DFF / 64) * (D / 32);
            for (int it = (cu - skipc) * NWAVES + wave; it < I_O2 + I_FO2; it += (G - skipc) * NWAVES) {
                if (it < I_O2) transpose_item(IN(I_WOUT), nullptr, D, D, WT_OUT, D, 0, 0, 0, scr, it, lane);
                else transpose_item(IN(I_WFFO), nullptr, DFF, D, WT_FFO, DFF, 0, 0, 0, scr, it - I_O2, lane); }
        }
        SchedS5 S{U2, WSB, (size_t)128 * S5K, S5K, 1, G, cu}; EpiS5E E{EE};
        pg8::gemm_phase(lds, S5K, S5P, S5K, S, E);
    }
    GSYNC();

    {
        PH_BEGIN
        const int gtr = (G - 1 - cu) * NT + tid;
        if (gtr < 32 * 8 * 64) { const int n = gtr & 63, b = (gtr >> 6) & 7, g = gtr >> 9;
            const float dt = expf(IN(I_LOGDT)[g]); const float lr = IN(I_ARE)[g * 64 + n], li = IN(I_AIM)[g * 64 + n]; float sn, cs; const float mg = expf(lr * dt * Q); sincosf(li * dt * Q, &sn, &cs);
            const float qr = mg * cs, qi = mg * sn; float xr = 0.f, xi = 0.f;
            const float* e = EE + ((size_t)g * S5R + b * NCH) * 128 + n; bf16_t* xo = U2 + ((size_t)g * S5R + b * NCH) * S5P + S5K + n;
            float er[NCH], ei[NCH];
#pragma unroll
            for (int k = 0; k < NCH; ++k) { er[k] = e[(size_t)k * 128]; ei[k] = e[(size_t)k * 128 + 64]; }
#pragma unroll
            for (int k = 0; k < NCH; ++k) { const unsigned w = cvt_pk_bf16(xr, xi); xo[(size_t)k * S5P] = (bf16_t)(w & 0xffff); xo[(size_t)k * S5P + 64] = (bf16_t)(w >> 16);
                const float nr = qr * xr - qi * xi + er[k], ni = qr * xi + qi * xr + ei[k]; xr = nr; xi = ni; }
            out[O_PSRE + (size_t)(b * 32 + g) * 64 + n] = xr; out[O_PSIM + (size_t)(b * 32 + g) * 64 + n] = xi; }
        SchedStatic S{LIN, WT_LORA, 256, 256, 65, 6, G, cu}; EpiLora E{LO, IN(I_W0), IN(I_A0)};
        pg8::gemm_phase(lds, 256, 256, 256, S, E);
    }
    GSYNC();

    {
        PH_BEGIN
        const float* mu = IN(I_MU);
        constexpr int TB = 32, STEPF = 6 * 64, BUFF = TB * STEPF;
        LAS float* ring = (LAS float*)lds;
        for (int rep = 0; rep < REP_WKV; ++rep)
        for (int it0 = cu; it0 < 256; it0 += G) {
            const int it = (G == 256) ? ((it0 & 7) * 32 + (it0 >> 3)) : it0;
            const int b = it >> 5, h = (it >> 2) & 7, q = it & 3;
            __syncthreads();
            if (wave >= 4) {
                const int ptid = tid - 256, c0 = (ptid & 15) * 4, j = h * 64 + c0, s0 = ptid >> 4;
                const f32x4 mur = *(const f32x4*)(mu + j), muk = *(const f32x4*)(mu + 512 + j), muv = *(const f32x4*)(mu + 1024 + j);
                const f32x4 kkv = *(const f32x4*)(IN(I_KK) + j), kav = *(const f32x4*)(IN(I_KA) + j), rkv = *(const f32x4*)(IN(I_RK) + j);
                u32x2 ld[2][8];
#define WKV_LOAD(blk) do { _Pragma("unroll") for (int e = 0; e < 2; ++e) { const int t = (blk) * TB + s0 + 16 * e; const size_t m = (size_t)b * T + t; const bf16_t* pr = PROJ + m * INW + j; const bf16_t* pp = pr - INW; \
                    ld[e][0] = *(const u32x2*)pr; ld[e][1] = *(const u32x2*)(pr + 512); ld[e][2] = *(const u32x2*)(pr + 1024); \
                    if (t > 0) { ld[e][3] = *(const u32x2*)pp; ld[e][4] = *(const u32x2*)(pp + 512); ld[e][5] = *(const u32x2*)(pp + 1024); } else { ld[e][3] = (u32x2){0u, 0u}; ld[e][4] = ld[e][3]; ld[e][5] = ld[e][3]; } \
                    ld[e][6] = *(const u32x2*)(LO + m * 1536 + j); ld[e][7] = *(const u32x2*)(LO + m * 1536 + 512 + j); } } while (0)
#define WKV_PROD(blk) do { _Pragma("unroll") for (int e = 0; e < 2; ++e) { const int s = s0 + 16 * e; const size_t m = (size_t)b * T + (blk) * TB + s; \
                    const f32x4 pr = unpack4(ld[e][0]), pk = unpack4(ld[e][1]), pv = unpack4(ld[e][2]), qr = unpack4(ld[e][3]), qk = unpack4(ld[e][4]), qv = unpack4(ld[e][5]), lw = unpack4(ld[e][6]), la = unpack4(ld[e][7]); \
                    const f32x4 r = pr + (qr - pr) * mur, k = pk + (qk - pk) * muk, v = pv + (qv - pv) * muv; f32x4 dec, av, kk, k2; float ss = 0.f, bn = 0.f; \
                    _Pragma("unroll") for (int x = 0; x < 4; ++x) { dec[x] = fexp(-lw[x]); av[x] = la[x]; \
                        kk[x] = k[x] * kkv[x]; ss += kk[x] * kk[x]; k2[x] = k[x] * (1.0f + (av[x] - 1.0f) * kav[x]); bn += r[x] * k2[x] * rkv[x]; } \
                    ss = red16(ss); bn = red16(bn); const float inv = 1.0f / fmaxf(sqrtf(ss), 1e-12f); kk = kk * inv; \
                    if (q == 0 && (ptid & 15) == 0) BONUS[m * 8 + h] = bn; \
                    LAS float* o = wb + s * STEPF + c0; *(LAS f32x4*)o = dec; *(LAS f32x4*)(o + 64) = -kk; *(LAS f32x4*)(o + 128) = kk * av; *(LAS f32x4*)(o + 192) = k2; *(LAS f32x4*)(o + 256) = r; *(LAS f32x4*)(o + 320) = v; } } while (0)
                { WKV_LOAD(0); LAS float* wb = ring; WKV_PROD(0); WKV_LOAD(1); }
                asm volatile("s_waitcnt lgkmcnt(0)" ::: "memory"); __builtin_amdgcn_s_barrier();
                for (int i = 0; i < T / TB; ++i) {
                    if (i + 1 < T / TB) { LAS float* wb = ring + ((i + 1) & 1) * BUFF; WKV_PROD(i + 1); if (i + 2 < T / TB) WKV_LOAD(i + 2); }
                    asm volatile("s_waitcnt lgkmcnt(0)" ::: "memory"); __builtin_amdgcn_s_barrier();
                }
#undef WKV_LOAD
#undef WKV_PROD
            } else {
                const int kq = lane & 15, row = q * 16 + wave * 4 + (lane >> 4);
                f32x2 Sa = (f32x2){0.f, 0.f}, Sb = Sa;
                typedef __attribute__((address_space(1))) bf16_t gbf;
                gbf* yo = (gbf*)(YWKV + ((size_t)b * T + kq) * 512 + h * 64 + row);
                asm volatile("s_waitcnt lgkmcnt(0)" ::: "memory"); __builtin_amdgcn_s_barrier();
#define WKV_LD(P, s_) do { \
                    asm volatile("ds_read_b128 %0, %1 offset:%2" : "=v"(P##w) : "v"(rba), "n"((s_) * 1536)); \
                    asm volatile("ds_read_b128 %0, %1 offset:%2" : "=v"(P##n) : "v"(rba), "n"((s_) * 1536 + 256)); \
                    asm volatile("ds_read_b128 %0, %1 offset:%2" : "=v"(P##b) : "v"(rba), "n"((s_) * 1536 + 512)); \
                    asm volatile("ds_read_b128 %0, %1 offset:%2" : "=v"(P##k) : "v"(rba), "n"((s_) * 1536 + 768)); \
                    asm volatile("ds_read_b128 %0, %1 offset:%2" : "=v"(P##r) : "v"(rba), "n"((s_) * 1536 + 1024)); \
                    asm volatile("ds_read_b32 %0, %1 offset:%2" : "=v"(P##v) : "v"(rva), "n"((s_) * 1536)); } while (0)
#define WKV_WAIT(P, n_) asm volatile("s_waitcnt lgkmcnt(" #n_ ")" : "+v"(P##w), "+v"(P##n), "+v"(P##b), "+v"(P##k), "+v"(P##r), "+v"(P##v))
#define WKV_UPD(src) do { \
                    f32x2 d2 = Sa * (f32x2){src##n[0], src##n[1]}; d2 = Sb * (f32x2){src##n[2], src##n[3]} + d2; float sa = d2[0] + d2[1]; sa = red16(sa); \
                    const f32x2 sa2 = (f32x2){sa, sa}, vv2 = (f32x2){src##v, src##v}; \
                    f32x2 ta = sa2 * (f32x2){src##b[0], src##b[1]}; ta = vv2 * (f32x2){src##k[0], src##k[1]} + ta; Sa = Sa * (f32x2){src##w[0], src##w[1]} + ta; \
                    f32x2 tb = sa2 * (f32x2){src##b[2], src##b[3]}; tb = vv2 * (f32x2){src##k[2], src##k[3]} + tb; Sb = Sb * (f32x2){src##w[2], src##w[3]} + tb; } while (0)
#define WKV_Y(rv, sidx) do { f32x2 y2 = Sa * (f32x2){rv[0], rv[1]}; y2 = Sb * (f32x2){rv[2], rv[3]} + y2; float y = y2[0] + y2[1]; y = red16(y); \
                    ykeep = (kq == ((sidx) & 15)) ? y : ykeep; if ((((sidx) + 1) & 15) == 0) yo[(size_t)(i * TB + (sidx) - 15) * 512] = (bf16_t)(cvt_pk_bf16(ykeep, 0.f) & 0xffffu); } while (0)
#define WKV_PAIR(s_) do { WKV_LD(B, (s_) + 1); WKV_WAIT(A, 6); if ((s_) > 0) WKV_Y(rq, (s_) - 1); rp = Ar; WKV_UPD(A); \
                    if ((s_) + 2 < TB) { WKV_LD(A, ((s_) + 2) & 31); WKV_WAIT(B, 6); } else { WKV_WAIT(B, 0); } WKV_Y(rp, (s_)); rq = Br; WKV_UPD(B); } while (0)
                for (int i = 0; i < T / TB; ++i) {
                    const unsigned rba = (unsigned)((i & 1) * BUFF * 4 + kq * 16), rva = (unsigned)((i & 1) * BUFF * 4 + (320 + row) * 4);
                    f32x4 Aw, An, Ab, Ak, Ar, Bw, Bn, Bb, Bk, Br, rp, rq; float Av, Bv, ykeep = 0.f;
                    WKV_LD(A, 0);
                    WKV_PAIR(0); WKV_PAIR(2); WKV_PAIR(4); WKV_PAIR(6); WKV_PAIR(8); WKV_PAIR(10); WKV_PAIR(12); WKV_PAIR(14);
                    WKV_PAIR(16); WKV_PAIR(18); WKV_PAIR(20); WKV_PAIR(22); WKV_PAIR(24); WKV_PAIR(26); WKV_PAIR(28); WKV_PAIR(30);
                    WKV_Y(rq, 31);
                    asm volatile("s_waitcnt lgkmcnt(0)" ::: "memory"); __builtin_amdgcn_s_barrier();
                }
#undef WKV_UPD
#undef WKV_Y
#undef WKV_PAIR
#undef WKV_WAIT
#undef WKV_LD
                *(f32x4*)(out + O_PWKV + (((size_t)(b * 8 + h) * 64 + row) * 64) + kq * 4) = (f32x4){Sa[0], Sa[1], Sb[0], Sb[1]};
            }
        }
        __syncthreads();
        {
            LAS float* ops = (LAS float*)lds;
            const int hb = (G >= 256) ? G / 2 : 0;
            for (int it = cu - hb; it >= 0 && it < 128; it += G - hb) {
                const int bh = it * 8 + wave, b = bh >> 3, h = bh & 7, c = lane, j = h * 64 + c; const size_t m = MP + b;
                __syncthreads();
                { const bf16_t* pr = PROJ + m * INW + j; const float* st = IN(I_SSHIFT) + (size_t)b * SHW + j;
                  const float p_r = bf1(pr[0]), p_k = bf1(pr[512]), p_v = bf1(pr[1024]);
                  const float r = p_r + (st[0] - p_r) * mu[j], k = p_k + (st[512] - p_k) * mu[512 + j], v = p_v + (st[1024] - p_v) * mu[1024 + j];
                  const float dec = fexp(-bf1(LO[m * 1536 + j]));
                  const float av = bf1(LO[m * 1536 + 512 + j]); float kk = k * IN(I_KK)[j]; const float ss = wave_sum(kk * kk); kk = kk / fmaxf(sqrtf(ss), 1e-12f);
                  const float k2 = k * (1.0f + (av - 1.0f) * IN(I_KA)[j]); const float bn = wave_sum(r * k2 * IN(I_RK)[j]); if (lane == 0) BONUS[m * 8 + h] = bn;
                  LAS float* o = ops + wave * STEPF + c; o[0] = dec; o[64] = -kk; o[128] = kk * av; o[192] = k2; o[256] = r; o[320] = v; }
                __syncthreads();
                { const LAS float* o = ops + wave * STEPF; const int v = lane; const float* sp = IN(I_SWKV) + ((size_t)bh * 64 + v) * 64; float* so = out + O_SWKV + ((size_t)bh * 64 + v) * 64;
                  f32x4 Sv[16]; float sa = 0.f;
#pragma unroll
                  for (int x = 0; x < 16; ++x) { Sv[x] = *(const f32x4*)(sp + 4 * x); const f32x4 nk = *(const LAS f32x4*)(o + 64 + 4 * x); sa += (Sv[x][0] * nk[0] + Sv[x][1] * nk[1]) + (Sv[x][2] * nk[2] + Sv[x][3] * nk[3]); }
                  const float vv = o[320 + v]; float y = 0.f;
#pragma unroll
                  for (int x = 0; x < 16; ++x) { const f32x4 w = *(const LAS f32x4*)(o + 4 * x), bb = *(const LAS f32x4*)(o + 128 + 4 * x), k = *(const LAS f32x4*)(o + 192 + 4 * x), r = *(const LAS f32x4*)(o + 256 + 4 * x);
                      const f32x4 sn = Sv[x] * w + (bb * sa + k * vv); *(f32x4*)(so + 4 * x) = sn; y += (sn[0] * r[0] + sn[1] * r[1]) + (sn[2] * r[2] + sn[3] * r[3]); }
                  YWKV[m * 512 + h * 64 + v] = (bf16_t)(cvt_pk_bf16(y, 0.f) & 0xffffu); }
            }
            __syncthreads();
        }
        for (int it = (cu - ((G >= 256) ? G / 2 : 0)) * NWAVES + wave; it >= 0 && it < 128 * 32; it += (G - ((G >= 256) ? G / 2 : 0)) * NWAVES) { const int b = it >> 5, g = it & 31, n = lane; const size_t m = MP + b;
            const float dt = __expf(IN(I_LOGDT)[g]); const float lr = IN(I_ARE)[g * 64 + n], li = IN(I_AIM)[g * 64 + n]; float sn, cs; const float mg = __expf(lr * dt); sincosf(li * dt, &sn, &cs);
            const float ar = mg * cs, ai = mg * sn, den = lr * lr + li * li, fr_ = ((ar - 1.0f) * lr + ai * li) / den, fi_ = (ai * lr - (ar - 1.0f) * li) / den;
            const float x0r = IN(I_SSRE)[((size_t)b * 32 + g) * 64 + n], x0i = IN(I_SSIM)[((size_t)b * 32 + g) * 64 + n];
            float xr = ar * x0r - ai * x0i, xi = ar * x0i + ai * x0r;
            const bf16_t* up = PROJ + m * INW + COL_U + g * 16;
#pragma unroll
            for (int c = 0; c < 16; ++c) { const float uu = bf1(up[c]); const float br = IN(I_BRE)[(g * 64 + n) * 16 + c], bi = IN(I_BIM)[(g * 64 + n) * 16 + c]; xr += uu * (fr_ * br - fi_ * bi); xi += uu * (fr_ * bi + fi_ * br); }
            out[O_SSRE + ((size_t)b * 32 + g) * 64 + n] = xr; out[O_SSIM + ((size_t)b * 32 + g) * 64 + n] = xi;
            float myz = 0.f;
#pragma unroll
            for (int c = 0; c < 16; ++c) { float yv = IN(I_CRE)[(g * 16 + c) * 64 + n] * xr - IN(I_CIM)[(g * 16 + c) * 64 + n] * xi; yv = wave_sum(yv); if (lane == c) myz = yv; }
            if (lane < 16) { const float uu = bf1(up[lane]); const float ys = myz + IN(I_DSK)[g * 16 + lane] * uu; const unsigned w = cvt_pk_bf16(gelu_t(ys), 0.f); ZB[m * 512 + g * 16 + lane] = (bf16_t)(w & 0xffff); }
        }
        SchedS5 S{U2, BTY, (size_t)512 * S5P, S5P, 2, G, cu}; EpiS5Y E{ZB, U2, IN(I_DSK)};
        pg8::gemm_phase(lds, S5P, S5P, S5P, S, E);
    }
    GSYNC();

    {
        PH_BEGIN
        const float* mu = IN(I_MU);
        {
            const int j0 = lane * 8, h = lane >> 3;
            const f32x4 mu0 = *(const f32x4*)(mu + 1024 + j0), mu1 = *(const f32x4*)(mu + 1024 + j0 + 4);
            const f32x4 lg0 = *(const f32x4*)(IN(I_LNXG) + j0), lg1 = *(const f32x4*)(IN(I_LNXG) + j0 + 4), lb0 = *(const f32x4*)(IN(I_LNXB) + j0), lb1 = *(const f32x4*)(IN(I_LNXB) + j0 + 4);
            for (int rep = 0; rep < REP_P5; ++rep)
#pragma unroll 2
            for (int m = gw; m < MV; m += NGW) {
                f32x4 y0, y1; unpack8(LDNT(u32x4, YWKV + (size_t)m * 512 + j0), y0, y1);
                f32x4 p0, p1, q0, q1, g0, g1; unpack8(LDNT(u32x4, PROJ + (size_t)m * INW + 1024 + j0), p0, p1); unpack8(LDNT(u32x4, LO + (size_t)m * 1536 + 1024 + j0), g0, g1);
                if (m >= MP) { const float* st = IN(I_SSHIFT) + (size_t)(m - MP) * SHW + 1024 + j0; q0 = *(const f32x4*)st; q1 = *(const f32x4*)(st + 4); }
                else if ((m & 2047) == 0) { q0 = (f32x4){0.f, 0.f, 0.f, 0.f}; q1 = q0; }
                else unpack8(*(const u32x4*)(PROJ + (size_t)(m - 1) * INW + 1024 + j0), q0, q1);
                const float bn = BONUS[(size_t)m * 8 + h];
                float sm = ((y0[0] + y0[1]) + (y0[2] + y0[3])) + ((y1[0] + y1[1]) + (y1[2] + y1[3]));
                sm += dppf<0xB1>(sm); sm += dppf<0x4E>(sm); sm += dppf<0x141>(sm);
                const float mean = sm * (1.0f / 64.0f); const f32x4 d0 = y0 - mean, d1 = y1 - mean;
                float vs = sq4(d0) + sq4(d1); vs += dppf<0xB1>(vs); vs += dppf<0x4E>(vs); vs += dppf<0x141>(vs);
                const float rs = __builtin_amdgcn_rsqf(vs * (1.0f / 64.0f) + GN_EPS);
                const f32x4 v0 = p0 + (q0 - p0) * mu0, v1 = p1 + (q1 - p1) * mu1;
                const f32x4 o0 = (d0 * rs * lg0 + lb0 + v0 * bn) * g0, o1 = (d1 * rs * lg1 + lb1 + v1 * bn) * g1;
                *(u32x4*)(YG + (size_t)m * 512 + j0) = pack8(o0, o1);
            }
        }
        for (int i = gt; i < (M - MV) * 512; i += NGT) YG[(size_t)MV * 512 + i] = 0;
        __syncthreads();
        LAS float* scr = (LAS float*)(lds + wave * 16384);
        constexpr int I_O = (D / 64) * (D / 32), I_FI = (D / 64) * (2 * DFF / 32), I_FO = (DFF / 64) * (D / 32), I_PL = (PLE / 64) * (D / 32);
        constexpr int NITEMS = I_O + I_FI + I_PL; (void)I_FO;
        for (int it = gw; it < NITEMS; it += NGW) {
            int r = it;
            if (r < I_O) { transpose_item(IN(I_WPG), IN(I_LN3), D, D, WT_PG, D, 0, 0, 0, scr, r, lane); continue; } r -= I_O;
            if (r < I_FI) { transpose_item(IN(I_WFFI), IN(I_LN2), D, 2 * DFF, WT_FFI, D, 0, 0, DFF, scr, r, lane); continue; } r -= I_FI;
            transpose_item(IN(I_WPLE), nullptr, PLE, D, WT_PLE, PLE, 0, 0, 0, scr, r, lane);
        }
    }
    GSYNC();

    {
        PH_BEGIN
        { LAS f32x4* red = (LAS f32x4*)lds; const int fr = lane & 15, fq = lane >> 4;
          for (int t = cu; t < 8 * 64; t += G) { const int rb = t & 7, cb = t >> 3, j0 = cb * 16, row = MP + rb * 16 + fr, col = j0 + 4 * fq;
            const bf16_t* wa = WT_GLU + (size_t)((j0 >> 7) * 256 + (j0 & 127)) * 512;
            skinny_put(red, 0, wave, lane, skinny_part(ZB + (size_t)(MP + rb * 16) * 512, 512, wa, 512, wave * 64, 64, fr, fq));
            skinny_put(red, 1, wave, lane, skinny_part(ZB + (size_t)(MP + rb * 16) * 512, 512, wa + 128 * 512, 512, wave * 64, 64, fr, fq));
            skinny_put(red, 2, wave, lane, skinny_part(YG + (size_t)(MP + rb * 16) * 512, 512, WT_RW + (size_t)j0 * 512, 512, wave * 64, 64, fr, fq));
            __syncthreads();
            if (wave == 0) { const f32x4 za = skinny_get(red, 0, lane), zb = skinny_get(red, 1, lane), rr = skinny_get(red, 2, lane);
                const f32x4 g1 = unpack4(*(const u32x2*)(PROJ + (size_t)row * INW + COL_G1 + col)), g2 = unpack4(*(const u32x2*)(PROJ + (size_t)row * INW + COL_G2 + col));
                *(u32x2*)(MG + (size_t)row * D + col) = pack4(sigm4(g1) * rr + sigm4(g2) * za * sigm4(zb)); }
            __syncthreads(); } }
        SchedGluRw S{ZB, YG, WT_GLU, WT_RW, 64, G, cu}; EpiGluRw E{T1, MG, PROJ};
        pg8::gemm_phase(lds, 512, 512, 512, S, E);
    }
    GSYNC();

    {
        PH_BEGIN
        { LAS f32x4* red = (LAS f32x4*)lds; const int fr = lane & 15, fq = lane >> 4;
          for (int t = cu; t < 8 * 64; t += G) { const int rb = t & 7, cb = t >> 3, row = MP + rb * 16 + fr, col = cb * 16 + 4 * fq;
            skinny_put(red, 0, wave, lane, skinny_part(MG + (size_t)(MP + rb * 16) * D, D, WT_OUT + (size_t)cb * 16 * D, D, wave * 128, 128, fr, fq));
            __syncthreads();
            if (wave == 0) { const f32x4 v = *(const f32x4*)(IN(I_XS) + (size_t)(rb * 16 + fr) * D + col) + skinny_get(red, 0, lane);
                *(u32x2*)(XB + (size_t)row * D + col) = pack4(v);
                float sq = sq4(v); sq += __shfl_xor(sq, 16); sq += __shfl_xor(sq, 32); if (fq == 0) atomicAdd(SSQ2 + row, sq); }
            __syncthreads(); } }
        SchedStatic S{MG, WT_OUT, D, D, 64, 4, G, cu}; EpiRes1 E{IN(I_XP), IN(I_XS), XB, SSQ2};
        pg8::gemm_phase(lds, D, D, D, S, E);
    }
    GSYNC();

    {
        PH_BEGIN
        SchedStatic S{XB, WT_FFI, D, D, 65, 22, G, cu}; EpiFfn E{HG, SSQ2, IN(I_CW), IN(I_CB), SA, SB, IN(I_SCONV), out, (LAS float*)(lds + XLDS_OFF)};
        for (int rep = 0; rep < REP_P9; ++rep) pg8::gemm_phase(lds, D, D, D, S, E);
        { const int extra = (65 * 22) % G; SchedTail S2{PBF, WT_PLE, PLE, PLE, extra, G - extra, 64 * 4, 4, cu}; EpiBf E2{PEB, D}; pg8::gemm_phase(lds, PLE, PLE, PLE, S2, E2); }
    }
    GSYNC();

    {
        PH_BEGIN
        { LAS f32x4* red = (LAS f32x4*)lds; const int fr = lane & 15, fq = lane >> 4;
          for (int t = cu; t < 8 * 64; t += G) { const int rb = t & 7, cb = t >> 3, row = MP + rb * 16 + fr, col = cb * 16 + 4 * fq;
            skinny_put(red, 0, wave, lane, skinny_part(HG + (size_t)(MP + rb * 16) * DFF, DFF, WT_FFO + (size_t)cb * 16 * DFF, DFF, wave * 352, 352, fr, fq));
            __syncthreads();
            if (wave == 0) { const f32x4 v = unpack4(*(const u32x2*)(XB + (size_t)row * D + col)) + skinny_get(red, 0, lane);
                *(u32x2*)(XB + (size_t)row * D + col) = pack4(v);
                float sq = sq4(v); sq += __shfl_xor(sq, 16); sq += __shfl_xor(sq, 32); if (fq == 0) atomicAdd(SSQ3 + row, sq); }
            __syncthreads(); } }
        SchedStatic S{HG, WT_FFO, DFF, DFF, 64, 4, G, cu}; EpiRes2 E{XB, SSQ3};
        const float* cw = IN(I_CW); const float* cb = IN(I_CB);
        for (int i = 0;; ++i) { Unit u; if (!S.next(i, u)) break; const int pm = u.pm; if (pm >= 64 || (pm & 7) == 0) continue;
            for (int e = tid; e < 2 * (DFF / 4); e += NT) { const int r = e / (DFF / 4), col = (e % (DFF / 4)) * 4;
                const f32x4 am2 = *(const f32x4*)(SA + ((size_t)(pm - 1) * 4 + 2) * DFF + col), am1 = *(const f32x4*)(SA + ((size_t)(pm - 1) * 4 + 3) * DFF + col);
                const f32x4 a0 = *(const f32x4*)(SA + ((size_t)pm * 4 + 0) * DFF + col), a1 = *(const f32x4*)(SA + ((size_t)pm * 4 + 1) * DFF + col);
                const f32x4 w0 = *(const f32x4*)(cw + col), w1 = *(const f32x4*)(cw + DFF + col), w2 = *(const f32x4*)(cw + 2 * DFF + col), bb = *(const f32x4*)(cb + col);
                const f32x4 sb = *(const f32x4*)(SB + ((size_t)pm * 2 + r) * DFF + col);
                const f32x4 cv = r == 0 ? (w0 * am2 + w1 * am1 + w2 * a0 + bb) : (w0 * am1 + w1 * a0 + w2 * a1 + bb);
                *(u32x2*)(HG + ((size_t)pm * 256 + r) * DFF + col) = pack4(gelu4(cv) * sb); } }
        asm volatile("s_waitcnt vmcnt(0)" ::: "memory"); __threadfence(); __syncthreads();
        pg8::gemm_phase(lds, DFF, DFF, DFF, S, E);
    }
    GSYNC();

    {
        PH_BEGIN
        unsigned* ctl = (unsigned*)(ws + SM_BAR);
        { LAS f32x4* red = (LAS f32x4*)lds; const int fr = lane & 15, fq = lane >> 4;
          for (int t = cu; t < 8 * 64; t += G) { const int rb = t & 7, cb = t >> 3, row = MP + rb * 16 + fr, col = cb * 16 + 4 * fq;
            skinny_put(red, 0, wave, lane, skinny_part(PBF + (size_t)(MP + rb * 16) * PLE, PLE, WT_PLE + (size_t)cb * 16 * PLE, PLE, wave * 32, 32, fr, fq));
            skinny_put(red, 1, wave, lane, skinny_part(XB + (size_t)(MP + rb * 16) * D, D, WT_PG + (size_t)cb * 16 * D, D, wave * 128, 128, fr, fq));
            __syncthreads();
            if (wave == 0) { const f32x4 pe = skinny_get(red, 0, lane), gg = skinny_get(red, 1, lane);
                const float rs = __builtin_amdgcn_rsqf(SSQ3[row] * (1.0f / D) + EPS);
                const f32x4 v = unpack4(*(const u32x2*)(XB + (size_t)row * D + col)) + sigm4(gg * rs) * pe;
                float* xo = X + (size_t)row * D + col;
#pragma unroll
                for (int e = 0; e < 4; ++e) __hip_atomic_store(xo + e, v[e], __ATOMIC_RELAXED, __HIP_MEMORY_SCOPE_AGENT);
                float sq = sq4(v); sq += __shfl_xor(sq, 16); sq += __shfl_xor(sq, 32); if (fq == 0) atomicAdd(SSQF + row, sq);
                asm volatile("s_waitcnt vmcnt(0)" ::: "memory");
                if (lane == 0) __hip_atomic_fetch_add(ctl + CW_SKINNY, 1u, __ATOMIC_RELAXED, __HIP_MEMORY_SCOPE_AGENT); }
            __syncthreads(); } }
        { SchedStatic S{XB, WT_PG, D, D, 64, 4, G, cu}; EpiPleFinal E{X, XB, PEB, SSQ3, SSQF, ctl + CW_PANEL, IN(I_FG)}; pg8::gemm_phase(lds, D, D, D, S, E); }
        if (wave == 0 && cu < MS) {
            unsigned sp = 0; while (__hip_atomic_load(ctl + CW_SKINNY, __ATOMIC_RELAXED, __HIP_MEMORY_SCOPE_AGENT) < 512u) { __builtin_amdgcn_s_sleep(2); if (++sp > (1u << 20)) break; }
            __builtin_amdgcn_fence(__ATOMIC_ACQUIRE, "agent"); asm volatile("s_waitcnt vmcnt(0)" ::: "memory");
            const int m = MP + cu; const float rs = __builtin_amdgcn_rsqf(__hip_atomic_load(SSQF + m, __ATOMIC_RELAXED, __HIP_MEMORY_SCOPE_AGENT) * (1.0f / D) + EPS);
            f32x4* xr = (f32x4*)(X + (size_t)m * D) + lane;
#pragma unroll
            for (int j = 0; j < 4; ++j) xr[64 * j] = xr[64 * j] * rs * *((const f32x4*)IN(I_FG) + lane + 64 * j);
        }
    }
    for (int i = 0; i < EXTRA_SYNC; ++i) GSYNC();
}

extern "C" void kernel_launch(void* const* d_in, const int* in_sizes, int n_in, void* d_out, int out_size, void* d_ws, size_t ws_size, hipStream_t stream) {
    static int grid = 0;
    if (grid == 0) {
        if (n_in != 42 || (size_t)out_size != O_END || ws_size < WS_END) { fprintf(stderr, "kernel_launch: unexpected sizes n_in %d out %d ws %zu (need %zu)\n", n_in, out_size, ws_size, (size_t)WS_END); grid = -1; return; }
        int dev = 0, cus = 0, per_cu = 0;
        if (hipGetDevice(&dev) != hipSuccess || hipDeviceGetAttribute(&cus, hipDeviceAttributeMultiprocessorCount, dev) != hipSuccess) { grid = -1; return; }
        if (hipFuncSetAttribute((const void*)fwd, hipFuncAttributeMaxDynamicSharedMemorySize, LDS_BYTES) != hipSuccess) { fprintf(stderr, "kernel_launch: hipFuncSetAttribute failed\n"); grid = -1; return; }
        if (hipOccupancyMaxActiveBlocksPerMultiprocessor(&per_cu, (const void*)fwd, NT, LDS_BYTES) != hipSuccess || per_cu < 1) { fprintf(stderr, "kernel_launch: occupancy query says %d\n", per_cu); (void)hipGetLastError(); grid = -1; return; }
        grid = cus;
    }
    if (grid < 0) return;
    if (hipMemsetAsync((char*)d_ws + SM_BAR, 0, (size_t)CTL_WORDS * 4, stream) != hipSuccess) { fprintf(stderr, "kernel_launch: memset failed\n"); return; }
    Args a{};
    for (int i = 0; i < 42; ++i) a.in[i] = (const float*)d_in[i];
    a.out = (float*)d_out; a.ws = (unsigned char*)d_ws;
    void* kargs[] = {&a};
    hipError_t e = hipLaunchCooperativeKernel((const void*)fwd, dim3(grid), dim3(NT), kargs, LDS_BYTES, stream);
    if (e != hipSuccess) fprintf(stderr, "kernel_launch: cooperative launch failed: %s\n", hipGetErrorString(e));
}
```
